# Optimizing an MI355X kernel written in HIP

```python
import math
import jax, jax.numpy as jnp
from jax import lax
import numpy as np

D_MODEL = 2048
BATCH = 4
SEQ = 4096
DEPTH = 1

D_MIX = D_MODEL
D_ATTN = D_MIX // 2
D_RWKV = D_MIX - D_ATTN
ATTN_HEAD_DIM = 64
ATTN_HEADS = D_ATTN // (2 * ATTN_HEAD_DIM)
ATTN_V_DIM = 2 * ATTN_HEAD_DIM
RWKV_HEAD = 64
RWKV_HEADS = D_RWKV // RWKV_HEAD
DECAY_LORA = 64
ICLR_LORA = 64
GATE_LORA = 160
D_IN = 3 * D_ATTN + 3 * D_RWKV
D_FF = 5632
CONV_W = 3
NUM_BUCKETS = 32
MAX_EXACT = NUM_BUCKETS // 2
MAX_DISTANCE = 128
Q_BLOCK = 128
NORM_EPS = 1e-6
RWKV_GN_EPS = 64e-5
NEG_INF = -1e30

kernel_name = "hybrid_diffattn_rwkv7_convffn_block"


def rmsnorm(x, g, eps=NORM_EPS):
    xf = x.astype(jnp.float32)
    y = xf * lax.rsqrt(jnp.mean(xf * xf, axis=-1, keepdims=True) + eps)
    return (y * g.astype(jnp.float32)).astype(x.dtype)


def token_shift(x):
    return jnp.pad(x, ((0, 0), (1, 0), (0, 0)))[:, :-1]


def t5_bucket(dist):
    n = jnp.maximum(dist, 0)
    nf = jnp.maximum(n, 1).astype(jnp.float32)
    large = MAX_EXACT + (jnp.log(nf / MAX_EXACT) / math.log(MAX_DISTANCE / MAX_EXACT)
                         * (NUM_BUCKETS - MAX_EXACT)).astype(jnp.int32)
    large = jnp.minimum(large, NUM_BUCKETS - 1)
    return jnp.where(n < MAX_EXACT, n, large)


def diff_attention(q, k, v, q_norm_g, k_norm_g, rel_bias, lam, subln_g, lambda_init):
    B, S = q.shape[0], q.shape[1]
    n_blk = S // Q_BLOCK
    q = rmsnorm(q, q_norm_g) * (ATTN_HEAD_DIM ** -0.5)
    k = rmsnorm(k, k_norm_g)
    kt = jnp.transpose(k, (0, 2, 3, 1, 4))
    vt = jnp.transpose(v, (0, 2, 1, 3))
    qb = jnp.transpose(q, (0, 2, 3, 1, 4)).reshape(B, ATTN_HEADS, 2, n_blk, Q_BLOCK, ATTN_HEAD_DIM)
    qb = jnp.transpose(qb, (3, 0, 1, 2, 4, 5))
    starts = jnp.arange(n_blk, dtype=jnp.int32) * Q_BLOCK
    key_pos = jnp.arange(S, dtype=jnp.int32)
    lam32 = lam.astype(jnp.float32)

    def block(args):
        q_blk, start = args
        s = jnp.einsum('bhiqd,bhikd->bhiqk', q_blk, kt).astype(jnp.float32)
        dist = (start + jnp.arange(Q_BLOCK, dtype=jnp.int32))[:, None] - key_pos[None, :]
        bias = jnp.transpose(rel_bias[t5_bucket(dist)], (2, 0, 1)).astype(jnp.float32)
        s = jnp.where(dist >= 0, s + bias[None, :, None], NEG_INF)
        p = jax.nn.softmax(s, axis=-1)
        attn = p[:, :, 0] - lam32 * p[:, :, 1]
        return jnp.einsum('bhqk,bhkv->bhqv', attn.astype(vt.dtype), vt)

    out = lax.map(block, (qb, starts))
    out = jnp.transpose(out, (1, 0, 3, 2, 4)).reshape(B, S, ATTN_HEADS, ATTN_V_DIM)
    out = rmsnorm(out, subln_g) * (1.0 - lambda_init)
    return out.reshape(B, S, D_ATTN)


def rwkv7_time_mix(h, r_p, k_p, v_p, mu_rkv, mu_wag, w0, w1, w2, a0, a1, a2, g1, g2,
                   k_k, k_a, r_k, ln_x_g, ln_x_b):
    B, S = h.shape[0], h.shape[1]
    f32 = jnp.float32
    r = r_p + (token_shift(r_p) - r_p) * mu_rkv[0]
    k = k_p + (token_shift(k_p) - k_p) * mu_rkv[1]
    v = v_p + (token_shift(v_p) - v_p) * mu_rkv[2]
    dh = token_shift(h) - h
    xw = h + dh * mu_wag[0]
    xa = h + dh * mu_wag[1]
    xg = h + dh * mu_wag[2]
    w = -jax.nn.softplus(-(w0 + jnp.tanh(xw @ w1) @ w2).astype(f32)) - 0.5
    decay = jnp.exp(-jnp.exp(w))
    a = jax.nn.sigmoid((a0 + (xa @ a1) @ a2).astype(f32))
    g = jax.nn.sigmoid(xg @ g1) @ g2
    k32 = k.astype(f32)
    kk = (k32 * k_k.astype(f32)).reshape(B, S, RWKV_HEADS, RWKV_HEAD)
    kk = kk / jnp.maximum(jnp.linalg.norm(kk, axis=-1, keepdims=True), 1e-12)
    k32 = k32 * (1.0 + (a - 1.0) * k_a.astype(f32))
    hs = lambda t: t.astype(f32).reshape(B, S, RWKV_HEADS, RWKV_HEAD)
    r32, w32, k32, v32, a32 = hs(r), hs(decay), hs(k32), hs(v), hs(a)
    tm = lambda t: jnp.moveaxis(t, 1, 0)

    def step(state, inp):
        r_t, w_t, k_t, v_t, kk_t, a_t = inp
        sa = jnp.einsum('bhvk,bhk->bhv', state, -kk_t)
        state = (state * w_t[:, :, None, :] + sa[..., None] * (kk_t * a_t)[:, :, None, :]
                 + v_t[..., None] * k_t[:, :, None, :])
        y_t = jnp.einsum('bhvk,bhk->bhv', state, r_t)
        return state, y_t

    s0 = jnp.zeros((B, RWKV_HEADS, RWKV_HEAD, RWKV_HEAD), f32)
    _, y = lax.scan(step, s0, (tm(r32), tm(w32), tm(k32), tm(v32), tm(kk), tm(a32)))
    y = jnp.moveaxis(y, 0, 1)
    mu = jnp.mean(y, axis=-1, keepdims=True)
    var = jnp.mean(jnp.square(y - mu), axis=-1, keepdims=True)
    yn = ((y - mu) * lax.rsqrt(var + RWKV_GN_EPS) * ln_x_g.astype(f32).reshape(RWKV_HEADS, RWKV_HEAD)
          + ln_x_b.astype(f32).reshape(RWKV_HEADS, RWKV_HEAD))
    bonus = jnp.sum(r32 * k32 * r_k.astype(f32), axis=-1, keepdims=True) * v32
    out = (yn + bonus).reshape(B, S, D_RWKV)
    return (out * g.astype(f32)).astype(h.dtype)


def conv_glu_ffn(h, w_up, conv_w, conv_b, w_down):
    S = h.shape[1]
    up = h @ w_up
    upp = jnp.pad(up, ((0, 0), (CONV_W - 1, 0), (0, 0)))
    y = conv_b + conv_w[0] * upp[:, 0:S] + conv_w[1] * upp[:, 1:S + 1] + conv_w[2] * upp[:, 2:S + 2]
    gate, val = jnp.split(y, 2, axis=-1)
    return (jax.nn.silu(gate) * val) @ w_down


def setup_inputs(seed: int = 0) -> dict:
    key = jax.random.key(seed)
    ks = iter(jax.random.split(key, 40))
    f32 = jnp.float32
    nrm = lambda shape, scale: jax.random.normal(next(ks), shape, f32) * scale
    L = DEPTH
    return {
        "x": nrm((BATCH, SEQ, D_MODEL), 1.0),
        "c": nrm((BATCH, D_MODEL), 1.0),
        "rel_bias": nrm((NUM_BUCKETS, ATTN_HEADS), 0.5),
        "w_ada": nrm((L, D_MODEL, 6 * D_MODEL), 0.5 * D_MODEL ** -0.5),
        "b_ada": nrm((L, 6 * D_MODEL), 0.02),
        "norm_mix_g": 1.0 + nrm((L, D_MODEL), 0.02),
        "w_in": nrm((L, D_MODEL, D_IN), D_MODEL ** -0.5),
        "q_norm_g": 1.0 + nrm((L, ATTN_HEAD_DIM), 0.02),
        "k_norm_g": 1.0 + nrm((L, ATTN_HEAD_DIM), 0.02),
        "lambda_q1": nrm((L, ATTN_HEAD_DIM), 0.1),
        "lambda_k1": nrm((L, ATTN_HEAD_DIM), 0.1),
        "lambda_q2": nrm((L, ATTN_HEAD_DIM), 0.1),
        "lambda_k2": nrm((L, ATTN_HEAD_DIM), 0.1),
        "attn_subln_g": 1.0 + nrm((L, ATTN_V_DIM), 0.02),
        "mu_rkv": jax.random.uniform(next(ks), (L, 3, D_RWKV), f32),
        "mu_wag": jax.random.uniform(next(ks), (L, 3, D_MODEL), f32),
        "w0": jax.random.uniform(next(ks), (L, D_RWKV), f32, -4.0, 1.0),
        "w1": nrm((L, D_MODEL, DECAY_LORA), D_MODEL ** -0.5),
        "w2": nrm((L, DECAY_LORA, D_RWKV), 0.3 * DECAY_LORA ** -0.5),
        "a0": nrm((L, D_RWKV), 0.1),
        "a1": nrm((L, D_MODEL, ICLR_LORA), D_MODEL ** -0.5),
        "a2": nrm((L, ICLR_LORA, D_RWKV), 0.5 * ICLR_LORA ** -0.5),
        "g1": nrm((L, D_MODEL, GATE_LORA), D_MODEL ** -0.5),
        "g2": nrm((L, GATE_LORA, D_RWKV), GATE_LORA ** -0.5),
        "k_k": 0.85 + nrm((L, D_RWKV), 0.02),
        "k_a": 1.0 + nrm((L, D_RWKV), 0.02),
        "r_k": nrm((L, RWKV_HEADS, RWKV_HEAD), 0.1),
        "ln_x_g": 1.0 + nrm((L, D_RWKV), 0.02),
        "ln_x_b": nrm((L, D_RWKV), 0.02),
        "w_out": nrm((L, D_MIX, D_MODEL), D_MIX ** -0.5),
        "norm_ffn_g": 1.0 + nrm((L, D_MODEL), 0.02),
        "w_up": nrm((L, D_MODEL, 2 * D_FF), D_MODEL ** -0.5),
        "conv_w": nrm((L, CONV_W, 2 * D_FF), CONV_W ** -0.5),
        "conv_b": nrm((L, 2 * D_FF), 0.02),
        "w_down": nrm((L, D_FF, D_MODEL), D_FF ** -0.5),
    }


def reference(x, c, rel_bias, w_ada, b_ada, norm_mix_g, w_in, q_norm_g, k_norm_g,
              lambda_q1, lambda_k1, lambda_q2, lambda_k2, attn_subln_g, mu_rkv, mu_wag,
              w0, w1, w2, a0, a1, a2, g1, g2, k_k, k_a, r_k, ln_x_g, ln_x_b, w_out,
              norm_ffn_g, w_up, conv_w, conv_b, w_down):
    B, S = x.shape[0], x.shape[1]
    c_act = jax.nn.silu(c)
    for l in range(DEPTH):
        lambda_init = 0.8 - 0.6 * math.exp(-0.3 * l)
        mod = c_act @ w_ada[l] + b_ada[l]
        shift_m, scale_m, gate_m, shift_f, scale_f, gate_f = jnp.split(mod, 6, axis=-1)

        h = rmsnorm(x, norm_mix_g[l]) * (1.0 + scale_m[:, None]) + shift_m[:, None]
        p = h @ w_in[l]
        q, k, v, r_p, kr_p, vr_p = jnp.split(p, 6, axis=-1)
        q = q.reshape(B, S, ATTN_HEADS, 2, ATTN_HEAD_DIM)
        k = k.reshape(B, S, ATTN_HEADS, 2, ATTN_HEAD_DIM)
        v = v.reshape(B, S, ATTN_HEADS, ATTN_V_DIM)
        lam = (jnp.exp(jnp.sum(lambda_q1[l].astype(jnp.float32) * lambda_k1[l].astype(jnp.float32)))
               - jnp.exp(jnp.sum(lambda_q2[l].astype(jnp.float32) * lambda_k2[l].astype(jnp.float32)))
               + lambda_init)
        o_attn = diff_attention(q, k, v, q_norm_g[l], k_norm_g[l], rel_bias, lam,
                                attn_subln_g[l], lambda_init)
        o_rwkv = rwkv7_time_mix(h, r_p, kr_p, vr_p, mu_rkv[l], mu_wag[l], w0[l], w1[l], w2[l],
                                a0[l], a1[l], a2[l], g1[l], g2[l], k_k[l], k_a[l], r_k[l],
                                ln_x_g[l], ln_x_b[l])
        mix = jnp.concatenate([o_attn, o_rwkv], axis=-1) @ w_out[l]
        x = x + gate_m[:, None] * mix

        h2 = rmsnorm(x, norm_ffn_g[l]) * (1.0 + scale_f[:, None]) + shift_f[:, None]
        x = x + gate_f[:, None] * conv_glu_ffn(h2, w_up[l], conv_w[l], conv_b[l], w_down[l])
    return x
```

```cpp
#include <hip/hip_runtime.h>
#include <hip/hip_bf16.h>
#include <cstdio>
#include <cstdint>
#include <cmath>
__device__ __forceinline__ int mk_lane_id() { int l; asm volatile("v_mbcnt_lo_u32_b32 %0, -1, 0\n\tv_mbcnt_hi_u32_b32 %0, -1, %0" : "=v"(l)); return l; }
namespace pg8 {
#define PG8_LAS __attribute__((address_space(3)))
typedef unsigned short bf16_t;
typedef short bf16x8 __attribute__((ext_vector_type(8)));
typedef float f32x4 __attribute__((ext_vector_type(4)));
typedef unsigned u32x4 __attribute__((ext_vector_type(4)));
constexpr int BM = 256, BK = 64, HALF = 128, HTB = HALF * BK * 2  , STAGE_BYTES = 8 * HTB, NXCD = 8, WGM = 8;

__host__ __device__ __forceinline__ int lds_byte(int r, int c) { const int st = (r >> 4) * 2 + (c >> 5), rr = r & 15, cc = c & 31, ob = rr * 64 + cc * 2; return st * 1024 + (ob ^ (((ob >> 9) & 1) << 5)); }
__host__ __device__ __forceinline__ void stage_rc(int b, int& R, int& C) { const int st = b / 1024, sb = b % 1024, swz = sb ^ (((sb >> 9) & 1) << 5); R = (st >> 1) * 16 + swz / 64; C = (st & 1) * 32 + (swz % 64) / 2; }
__host__ __device__ __forceinline__ int perm32(int rho) { const int n = rho >> 4, i = rho & 15; return 8 * (i >> 2) + 4 * n + (i & 3); }

struct Unit { int pm, pn; };
struct Gemm { const bf16_t* A; const bf16_t* A1; int pm_split; int lda; const bf16_t* Bt; int M, N, K; };

struct StaticOrder {
    int nM, nN, nwg, G, c;
    __host__ __device__ void init(int M, int N, int G_, int c_) { nM = M / BM; nN = N / BM; nwg = nM * nN; G = G_; c = c_; }
    __host__ __device__ bool next(int i, Unit& u) const {
        const long L = (long)i * G + c; if (L >= nwg) return false;
        int wgid = (int)L; { const int q = nwg / NXCD, r = nwg % NXCD, xcd = wgid % NXCD, off = wgid / NXCD; wgid = (xcd < r ? xcd * (q + 1) : r * (q + 1) + (xcd - r) * q) + off; }
        const int nig = WGM * nN, gid = wgid / nig, fm = gid * WGM, gsz = (nM - fm) < WGM ? (nM - fm) : WGM;
        u.pm = fm + ((wgid % nig) % gsz); u.pn = (wgid % nig) / gsz; return true;
    }
    __device__ __forceinline__ void a_ready(const Unit&) const {}
    __device__ __forceinline__ void done(const Unit&) const {}
};

__device__ __forceinline__ unsigned cvt_pk_bf16(float lo, float hi) { unsigned r; asm volatile("v_cvt_pk_bf16_f32 %0, %1, %2" : "=v"(r) : "v"(lo), "v"(hi)); return r; }
typedef float f32x2 __attribute__((ext_vector_type(2)));
__device__ __forceinline__ float sigmoidf_fast(float x) { return __builtin_amdgcn_rcpf(1.0f + __builtin_amdgcn_exp2f(-1.4426950408889634f * x)); }
__device__ __forceinline__ u32x4 pack8(const f32x4 v0, const f32x4 v1) { u32x4 w; w.x = cvt_pk_bf16(v0[0], v0[1]); w.y = cvt_pk_bf16(v0[2], v0[3]); w.z = cvt_pk_bf16(v1[0], v1[1]); w.w = cvt_pk_bf16(v1[2], v1[3]); return w; }

struct EpiStore {
    static constexpr bool PERM = true, AFTER_DRAIN = false;
    bf16_t* O; int ldc;
    __device__ __forceinline__ void operator()(const f32x4 (&acc)[2][2][4][2], const Unit& u, int wr, int wc, int fr, int fq) const {
        const int row0 = u.pm * BM + wr * 64 + fr, col0 = u.pn * BM + wc * 32 + 8 * fq;
#pragma unroll
        for (int ai = 0; ai < 2; ++ai)
#pragma unroll
            for (int m = 0; m < 4; ++m) { bf16_t* rowp = O + (size_t)(row0 + ai * HALF + m * 16) * ldc + col0;
#pragma unroll
                for (int bj = 0; bj < 2; ++bj) *(u32x4*)(rowp + bj * HALF) = pack8(acc[ai][bj][m][0], acc[ai][bj][m][1]); }
    }
};
struct EpiLora2 {
    static constexpr bool PERM = true, AFTER_DRAIN = false;
    bf16_t* O; const float* w0; const float* a0;
    __device__ __forceinline__ void operator()(const f32x4 (&acc)[2][2][4][2], const Unit& u, int wr, int wc, int fr, int fq) const {
        const int row0 = u.pm * BM + wr * 64 + fr, col0 = u.pn * BM + wc * 32 + 8 * fq, kind = u.pn >> 2, cl = col0 & 1023;
        f32x4 bv[2][2];
#pragma unroll
        for (int bj = 0; bj < 2; ++bj)
#pragma unroll
            for (int n = 0; n < 2; ++n) bv[bj][n] = kind == 0 ? *(const f32x4*)(w0 + cl + bj * HALF + 4 * n) : kind == 1 ? *(const f32x4*)(a0 + cl + bj * HALF + 4 * n) : (f32x4){0.f, 0.f, 0.f, 0.f};
#pragma unroll
        for (int ai = 0; ai < 2; ++ai)
#pragma unroll
            for (int m = 0; m < 4; ++m) { bf16_t* rowp = O + (size_t)(row0 + ai * HALF + m * 16) * 3072 + col0;
#pragma unroll
                for (int bj = 0; bj < 2; ++bj) { f32x4 v0 = acc[ai][bj][m][0] + bv[bj][0], v1 = acc[ai][bj][m][1] + bv[bj][1];
                    if (kind < 2) { const float sc = kind == 0 ? -0.6065306597126334f : 1.0f;
#pragma unroll
                        for (int e = 0; e < 4; ++e) { v0[e] = sc * sigmoidf_fast(v0[e]); v1[e] = sc * sigmoidf_fast(v1[e]); } }
                    *(u32x4*)(rowp + bj * HALF) = pack8(v0, v1); } }
    }
};
struct EpiUp {
    static constexpr bool PERM = true, AFTER_DRAIN = false;
    bf16_t* O; int ldc; const float* rowss; const float* biasf;
    __device__ __forceinline__ void operator()(const f32x4 (&acc)[2][2][4][2], const Unit& u, int wr, int wc, int fr, int fq) const {
        const int row0 = u.pm * BM + wr * 64 + fr, col0 = u.pn * BM + wc * 32 + 8 * fq, b = u.pm >> 4;
        f32x4 bv[2][2];
#pragma unroll
        for (int bj = 0; bj < 2; ++bj)
#pragma unroll
            for (int n = 0; n < 2; ++n) bv[bj][n] = *(const f32x4*)(biasf + (size_t)b * ldc + col0 + bj * HALF + 4 * n);
#pragma unroll
        for (int ai = 0; ai < 2; ++ai)
#pragma unroll
            for (int m = 0; m < 4; ++m) { const int row = row0 + ai * HALF + m * 16; const float rs = __builtin_amdgcn_rsqf(rowss[row] * (1.0f / 2048.0f) + 1e-6f);
                bf16_t* rowp = O + (size_t)row * ldc + col0;
#pragma unroll
                for (int bj = 0; bj < 2; ++bj) *(u32x4*)(rowp + bj * HALF) = pack8(acc[ai][bj][m][0] * rs + bv[bj][0], acc[ai][bj][m][1] * rs + bv[bj][1]); }
    }
};
struct EpiOut {
    static constexpr bool PERM = false, AFTER_DRAIN = false;
    const float* x; float* out; bf16_t* XG; float* rowss; const float* gate; const float* gs;
    int gstride;
    __device__ __forceinline__ void operator()(const f32x4 (&acc)[2][2][4][2], const Unit& u, int wr, int wc, int fr, int fq) const {
        typedef unsigned u32x2v __attribute__((ext_vector_type(2)));
        const int row0 = u.pm * BM + wr * 64 + fr, col0 = u.pn * BM + wc * 32 + 4 * fq, b = u.pm >> 4;
        f32x4 gv[2][2], sv[2][2];
#pragma unroll
        for (int bj = 0; bj < 2; ++bj)
#pragma unroll
            for (int n = 0; n < 2; ++n) { gv[bj][n] = *(const f32x4*)(gate + (size_t)b * gstride + col0 + bj * HALF + n * 16); sv[bj][n] = *(const f32x4*)(gs + (size_t)b * 2048 + col0 + bj * HALF + n * 16); }
#pragma unroll
        for (int ai = 0; ai < 2; ++ai)
#pragma unroll
            for (int m = 0; m < 4; ++m) { const int row = row0 + ai * HALF + m * 16; const size_t off = (size_t)row * 2048 + col0; float ss = 0.f;
#pragma unroll
                for (int bj = 0; bj < 2; ++bj)
#pragma unroll
                    for (int n = 0; n < 2; ++n) { const f32x4 xv = *(const f32x4*)(x + off + bj * HALF + n * 16); const f32x4 x1 = xv + gv[bj][n] * acc[ai][bj][m][n];
                        *(f32x4*)(out + off + bj * HALF + n * 16) = x1; ss += (x1[0] * x1[0] + x1[1] * x1[1]) + (x1[2] * x1[2] + x1[3] * x1[3]);
                        const f32x4 g4 = x1 * sv[bj][n]; u32x2v w; w.x = cvt_pk_bf16(g4[0], g4[1]); w.y = cvt_pk_bf16(g4[2], g4[3]); *(u32x2v*)(XG + off + bj * HALF + n * 16) = w; }
                ss += __shfl_xor(ss, 16); ss += __shfl_xor(ss, 32);
                if (fq == 0) atomicAdd(rowss + row, ss); }
    }
};
struct EpiDown {
    static constexpr bool PERM = false, AFTER_DRAIN = false;
    float* out; const float* gate; int gstride;
    __device__ __forceinline__ void operator()(const f32x4 (&acc)[2][2][4][2], const Unit& u, int wr, int wc, int fr, int fq) const {
        const int row0 = u.pm * BM + wr * 64 + fr, col0 = u.pn * BM + wc * 32 + 4 * fq, b = u.pm >> 4;
        f32x4 gv[2][2];
#pragma unroll
        for (int bj = 0; bj < 2; ++bj)
#pragma unroll
            for (int n = 0; n < 2; ++n) gv[bj][n] = *(const f32x4*)(gate + (size_t)b * gstride + col0 + bj * HALF + n * 16);
#pragma unroll
        for (int ai = 0; ai < 2; ++ai)
#pragma unroll
            for (int m = 0; m < 4; ++m) { const size_t off = (size_t)(row0 + ai * HALF + m * 16) * 2048 + col0;
#pragma unroll
                for (int bj = 0; bj < 2; ++bj)
#pragma unroll
                    for (int n = 0; n < 2; ++n) { float* p = out + off + bj * HALF + n * 16; *(f32x4*)p = *(const f32x4*)p + gv[bj][n] * acc[ai][bj][m][n]; } }
    }
};

template <class Epi, class Sched, bool ALIGN_EPI = false, bool SP2 = false>
__device__ __forceinline__ void gemm_phase(PG8_LAS unsigned char* lds, const Gemm g, const Sched& S, const Epi& E, const int wid) {
    const int lane = mk_lane_id(), tid = wid * 64 + lane, wr = wid >> 2, wc = wid & 3, fr = lane & 15, fq = lane >> 4;
    const int K = g.K, nt = K / BK, lda = g.lda;
    unsigned voffA[2], voffB[2];
#pragma unroll
    for (int i = 0; i < 2; ++i) { int R, C; stage_rc(tid * 16 + i * 8192, R, C); const int Rb = Epi::PERM ? ((R & ~31) + perm32(R & 31)) : R;
        voffA[i] = (unsigned)(R * lda + C) * 2u; voffB[i] = (unsigned)(Rb * K + C) * 2u; }
    const size_t kstep = (size_t)(BK * 2);
    const size_t hstepA = (size_t)HALF * lda * 2, hstepB = (size_t)HALF * K * 2;
    const size_t tstepA = 2 * hstepA, tstepB = 2 * hstepB;
#define PG8_ABASE(pm) ((pm) < g.pm_split ? (const char*)g.A + (size_t)(pm) * tstepA : (const char*)g.A1 + (size_t)((pm) - g.pm_split) * tstepA)
    const unsigned ldsw = (unsigned)wid * 1024u;
    const int aoff = lds_byte(wr * 64 + fr, fq * 8), boff = lds_byte(wc * 32 + fr, fq * 8);
#define PG8_SA(b, h) (((b) * 2 + (h)) * HTB)
#define PG8_SB(b, h) ((4 + (b) * 2 + (h)) * HTB)
#define PG8_STAGE(bufoff, gbase, voff) do { _Pragma("unroll") for (int _i = 0; _i < 2; ++_i) \
        __builtin_amdgcn_global_load_lds((const unsigned*)((const char*)(gbase) + (voff)[_i]), (PG8_LAS unsigned*)(lds + (bufoff) + ldsw + _i * 8192), 16, 0, 0); } while (0)
#define PG8_LDA(dst, b, h) do { _Pragma("unroll") for (int m = 0; m < 4; ++m) _Pragma("unroll") for (int k = 0; k < 2; ++k) dst[m][k] = *(const PG8_LAS bf16x8*)(lds + PG8_SA(b, h) + aoff + m * 2048 + k * 1024); } while (0)
#define PG8_LDB(dst, b, h) do { _Pragma("unroll") for (int n = 0; n < 2; ++n) _Pragma("unroll") for (int k = 0; k < 2; ++k) dst[n][k] = *(const PG8_LAS bf16x8*)(lds + PG8_SB(b, h) + boff + n * 2048 + k * 1024); } while (0)
#define PG8_MMA(ai, bj, At, Bt) do { __builtin_amdgcn_s_setprio(1); _Pragma("unroll") for (int m = 0; m < 4; ++m) _Pragma("unroll") for (int n = 0; n < 2; ++n) _Pragma("unroll") for (int k = 0; k < 2; ++k) \
        acc[ai][bj][m][n] = __builtin_amdgcn_mfma_f32_16x16x32_bf16(Bt[n][k], At[m][k], acc[ai][bj][m][n], 0, 0, 0); __builtin_amdgcn_s_setprio(0); } while (0)
#define PG8_WAIT_V(n) asm volatile("s_waitcnt vmcnt(" #n ")" ::: "memory")
#define PG8_WAIT_L(n) asm volatile("s_waitcnt lgkmcnt(" #n ")" ::: "memory")
#define PG8_BAR __builtin_amdgcn_s_barrier()
#define PG8_SCHED __builtin_amdgcn_sched_barrier(0)
    Unit cur, nxt; int ui = 0;
    if (!S.next(0, cur)) return;
    f32x4 acc[2][2][4][2];
#pragma unroll
    for (int a = 0; a < 2; ++a)
#pragma unroll
        for (int b = 0; b < 2; ++b)
#pragma unroll
            for (int m = 0; m < 4; ++m)
#pragma unroll
                for (int n = 0; n < 2; ++n) acc[a][b][m][n] = (f32x4){0.f, 0.f, 0.f, 0.f};
    bf16x8 At[4][2], B0[2][2], B1[2][2];
    const char* cA = PG8_ABASE(cur.pm); const char* cB = (const char*)g.Bt + (size_t)cur.pn * tstepB;
    S.a_ready(cur);
    if constexpr (SP2) {
        PG8_STAGE(PG8_SB(0, 0), cB, voffB); PG8_STAGE(PG8_SB(0, 1), cB + hstepB, voffB); PG8_STAGE(PG8_SA(0, 0), cA, voffA); PG8_STAGE(PG8_SA(0, 1), cA + hstepA, voffA);
        if (wr == 1) PG8_BAR;
        PG8_WAIT_V(2); PG8_BAR;
        PG8_STAGE(PG8_SB(1, 0), cB + kstep, voffB); PG8_STAGE(PG8_SA(1, 0), cA + kstep, voffA); PG8_STAGE(PG8_SB(1, 1), cB + hstepB + kstep, voffB);
        PG8_WAIT_V(6); PG8_BAR;
    } else {
        PG8_STAGE(PG8_SB(0, 0), cB, voffB); PG8_STAGE(PG8_SA(0, 0), cA, voffA); PG8_STAGE(PG8_SB(0, 1), cB + hstepB, voffB); PG8_STAGE(PG8_SA(0, 1), cA + hstepA, voffA);
        if (wr == 1) PG8_BAR;
        PG8_WAIT_V(4); PG8_BAR;
        PG8_STAGE(PG8_SB(1, 0), cB + kstep, voffB); PG8_STAGE(PG8_SA(1, 0), cA + kstep, voffA); PG8_STAGE(PG8_SB(1, 1), cB + hstepB + kstep, voffB);
        PG8_WAIT_V(6); PG8_BAR;
    }
    for (;;) {
        const bool has_next = S.next(ui + 1, nxt);
        const char* nA = has_next ? PG8_ABASE(nxt.pm) : cA; const char* nB = has_next ? (const char*)g.Bt + (size_t)nxt.pn * tstepB : cB;
        for (int t = 0; t < nt; t += 2) {
            const bool last = (t == nt - 2);
            const char* a1 = cA + (size_t)(t + 1) * kstep;
            const char* a2 = last ? nA : cA + (size_t)(t + 2) * kstep; const char* b2 = last ? nB : cB + (size_t)(t + 2) * kstep;
            const char* a3 = a2 + kstep; const char* b3 = b2 + kstep;
            if (last && has_next) S.a_ready(nxt);
            if constexpr (SP2) {
            PG8_LDB(B0, 0, 0); PG8_LDB(B1, 0, 1); PG8_SCHED; PG8_LDA(At, 0, 0); PG8_STAGE(PG8_SA(1, 1), a1 + hstepA, voffA);
            PG8_WAIT_V(8); PG8_WAIT_L(0); PG8_BAR; PG8_MMA(0, 0, At, B0); PG8_MMA(0, 1, At, B1); PG8_BAR; PG8_SCHED;
            PG8_LDA(At, 0, 1); PG8_STAGE(PG8_SB(0, 0), b2, voffB); PG8_STAGE(PG8_SB(0, 1), b2 + hstepB, voffB); PG8_STAGE(PG8_SA(0, 0), a2, voffA);
            PG8_WAIT_V(8); PG8_WAIT_L(0); PG8_BAR; PG8_MMA(1, 0, At, B0); PG8_MMA(1, 1, At, B1); PG8_BAR; PG8_SCHED;
            PG8_LDB(B0, 1, 0); PG8_LDB(B1, 1, 1); PG8_SCHED; PG8_LDA(At, 1, 0); PG8_STAGE(PG8_SA(0, 1), a2 + hstepA, voffA);
            PG8_WAIT_V(8); PG8_WAIT_L(0); PG8_BAR; PG8_MMA(0, 0, At, B0); PG8_MMA(0, 1, At, B1); PG8_BAR; PG8_SCHED;
            PG8_LDA(At, 1, 1); PG8_STAGE(PG8_SB(1, 0), b3, voffB); PG8_STAGE(PG8_SB(1, 1), b3 + hstepB, voffB); PG8_STAGE(PG8_SA(1, 0), a3, voffA);
            PG8_WAIT_V(8); PG8_WAIT_L(0); PG8_BAR; PG8_MMA(1, 0, At, B0); PG8_MMA(1, 1, At, B1); PG8_BAR; PG8_SCHED;
            } else {
            PG8_LDB(B0, 0, 0); PG8_SCHED; PG8_LDA(At, 0, 0); PG8_STAGE(PG8_SA(1, 1), a1 + hstepA, voffA);
            PG8_WAIT_L(8); PG8_BAR; PG8_WAIT_L(0); PG8_MMA(0, 0, At, B0); PG8_BAR; PG8_SCHED;
            PG8_LDB(B1, 0, 1); PG8_STAGE(PG8_SB(0, 0), b2, voffB);
            PG8_BAR; PG8_WAIT_L(0); PG8_MMA(0, 1, At, B1); PG8_BAR;
            PG8_LDA(At, 0, 1); PG8_STAGE(PG8_SA(0, 0), a2, voffA);
            PG8_BAR; PG8_WAIT_L(0); PG8_MMA(1, 0, At, B0); PG8_BAR; PG8_SCHED;
            PG8_STAGE(PG8_SB(0, 1), b2 + hstepB, voffB);
            PG8_WAIT_V(6); PG8_BAR; PG8_MMA(1, 1, At, B1); PG8_BAR;
            PG8_LDB(B0, 1, 0); PG8_SCHED; PG8_LDA(At, 1, 0); PG8_STAGE(PG8_SA(0, 1), a2 + hstepA, voffA);
            PG8_WAIT_L(8); PG8_BAR; PG8_WAIT_L(0); PG8_MMA(0, 0, At, B0); PG8_BAR; PG8_SCHED;
            PG8_LDB(B1, 1, 1); PG8_STAGE(PG8_SB(1, 0), b3, voffB);
            PG8_BAR; PG8_WAIT_L(0); PG8_MMA(0, 1, At, B1); PG8_BAR;
            PG8_LDA(At, 1, 1); PG8_STAGE(PG8_SA(1, 0), a3, voffA);
            PG8_BAR; PG8_WAIT_L(0); PG8_MMA(1, 0, At, B0); PG8_BAR; PG8_SCHED;
            PG8_STAGE(PG8_SB(1, 1), b3 + hstepB, voffB);
            PG8_WAIT_V(6); PG8_BAR; PG8_MMA(1, 1, At, B1); PG8_BAR;
            }
        }
        if constexpr (ALIGN_EPI) { if (wr == 0) PG8_BAR; }
        if constexpr (!Epi::AFTER_DRAIN) { E(acc, cur, wr, wc, fr, fq); S.done(cur); }
        if (!has_next) break;
#pragma unroll
        for (int a = 0; a < 2; ++a)
#pragma unroll
            for (int b = 0; b < 2; ++b)
#pragma unroll
                for (int m = 0; m < 4; ++m)
#pragma unroll
                    for (int n = 0; n < 2; ++n) acc[a][b][m][n] = (f32x4){0.f, 0.f, 0.f, 0.f};
        cur = nxt; cA = nA; cB = nB; ++ui;
        if constexpr (ALIGN_EPI) { if (wr == 1) PG8_BAR; }
    }
    PG8_WAIT_V(0);
    if constexpr (!ALIGN_EPI) { if (wr == 0) PG8_BAR; }
    PG8_BAR;
    if constexpr (Epi::AFTER_DRAIN) { E.fused(acc, cur, wr, wc, fr, fq, lds, wid, lane); S.done(cur); }
#undef PG8_ABASE
#undef PG8_SA
#undef PG8_SB
#undef PG8_STAGE
#undef PG8_LDA
#undef PG8_LDB
#undef PG8_MMA
#undef PG8_WAIT_V
#undef PG8_WAIT_L
#undef PG8_BAR
#undef PG8_SCHED
}
}

#include <hip/hip_bf16.h>
#include <cmath>
namespace attn_body {
using bf16=__hip_bfloat16;
using bf16x8=__attribute__((ext_vector_type(8)))short;
using s16x4=__attribute__((ext_vector_type(4)))short;
using f32x16=__attribute__((ext_vector_type(16)))float;
using u32x4=__attribute__((ext_vector_type(4)))unsigned;
constexpr int BATCH=4,SEQ=4096,D=64,DM=6912,OPITCH=2048;
constexpr int NW=8,QBLK=32,QB=QBLK*NW,KVBLK=64,NQB=SEQ/QB;
constexpr int ATTN_PITCH=DM, ATTN_UNIT_ROWS=QB;
__device__ __forceinline__ int crow(int r,int hi){return (r&3)+8*(r>>2)+4*hi;}
#define SBAR() __builtin_amdgcn_sched_barrier(0)
typedef __attribute__((address_space(3))) const float* lds_cfptr;
__device__ __forceinline__ void bias_add(f32x16&p0,f32x16&p1,lds_cfptr tabr,int cb){
  #pragma unroll
  for(int r=0;r<16;++r){const int k=(r&3)+8*(r>>2); p0[r]+=tabr[cb+k]; p1[r]+=tabr[cb+k+32];}
}
constexpr int LDS_TAB=86016, TAB_N=640;
constexpr int NSLOT=3, SLOTB=8192;
constexpr int LDS_K=0, LDS_V=NSLOT*SLOTB, LDS_WS=2*NSLOT*SLOTB, LDS_OST=LDS_WS+NW*64*4, LDS_BYTES=LDS_OST+NW*4096;
constexpr float C2=0.125f*1.4426950408889634f;
__device__ __forceinline__ void glds16(const void*gsrc,unsigned lds_dst){unsigned keep;
  asm volatile("s_mov_b32 %0, m0\n\ts_mov_b32 m0, %2\n\ts_nop 0\n\tglobal_load_lds_dwordx4 %1, off\n\ts_mov_b32 m0, %0":"=&s"(keep):"v"(gsrc),"s"(lds_dst):"memory");}
__device__ __forceinline__ float max3f(float a,float b,float c){float r;asm("v_max3_f32 %0, %1, %2, %3":"=v"(r):"v"(a),"v"(b),"v"(c));return r;}
__device__ __forceinline__ float max2f(float a,float b){float r;asm("v_max_f32_e32 %0, %1, %2":"=v"(r):"v"(a),"v"(b));return r;}
__device__ __forceinline__ float fadd_s(float a,float b){float r;asm("v_add_f32_e32 %0, %1, %2":"=v"(r):"v"(a),"v"(b));return r;}
__device__ __forceinline__ float fsub_s(float a,float b){float r;asm("v_sub_f32_e32 %0, %1, %2":"=v"(r):"v"(a),"v"(b));return r;}
typedef float f32x2_t __attribute__((ext_vector_type(2))); typedef __bf16 bf16x2_t __attribute__((ext_vector_type(2)));
__device__ __forceinline__ unsigned cvtpk_s(float lo,float hi){f32x2_t v={lo,hi};bf16x2_t b=__builtin_convertvector(v,bf16x2_t);return __builtin_bit_cast(unsigned,b);}
#define WAIT_BAR(N) asm volatile("s_waitcnt vmcnt(" #N ") lgkmcnt(0)\n\ts_barrier":::"memory")

__device__ __forceinline__ void qkt(f32x16&p0,f32x16&p1,const char*Kslot,const bf16x8*qr,const f32x16&negm,int r32,int hi){
  const char*kb=Kslot+hi*1024+r32*16;
  #pragma unroll
  for(int d0=0;d0<4;++d0){
    const bf16x8 b0=*reinterpret_cast<const bf16x8*>(kb+d0*2048);
    const bf16x8 b1=*reinterpret_cast<const bf16x8*>(kb+d0*2048+512);
    if(d0==0){p0=__builtin_amdgcn_mfma_f32_32x32x16_bf16(b0,qr[0],negm,0,0,0);p1=__builtin_amdgcn_mfma_f32_32x32x16_bf16(b1,qr[0],negm,0,0,0);}
    else{p0=__builtin_amdgcn_mfma_f32_32x32x16_bf16(b0,qr[d0],p0,0,0,0);p1=__builtin_amdgcn_mfma_f32_32x32x16_bf16(b1,qr[d0],p1,0,0,0);}}
}
typedef __attribute__((address_space(3))) const char* lds_cptr;
typedef short v4i16_t __attribute__((ext_vector_type(4)));
__device__ __forceinline__ void kload8(bf16x8*kf,lds_cptr kp){
  kf[0]=*(const __attribute__((address_space(3))) bf16x8*)(kp);      kf[1]=*(const __attribute__((address_space(3))) bf16x8*)(kp+512);
  kf[2]=*(const __attribute__((address_space(3))) bf16x8*)(kp+2048); kf[3]=*(const __attribute__((address_space(3))) bf16x8*)(kp+2560);
  kf[4]=*(const __attribute__((address_space(3))) bf16x8*)(kp+4096); kf[5]=*(const __attribute__((address_space(3))) bf16x8*)(kp+4608);
  kf[6]=*(const __attribute__((address_space(3))) bf16x8*)(kp+6144); kf[7]=*(const __attribute__((address_space(3))) bf16x8*)(kp+6656);
}
__device__ __forceinline__ void kload2(bf16x8*kf,lds_cptr kp,int j){ kf[2*j]=*(const __attribute__((address_space(3))) bf16x8*)(kp+j*2048); kf[2*j+1]=*(const __attribute__((address_space(3))) bf16x8*)(kp+j*2048+512); }
__device__ __forceinline__ s16x4 vtr(lds_cptr p){ return __builtin_bit_cast(s16x4,__builtin_amdgcn_ds_read_tr16_b64_v4i16((__attribute__((address_space(3))) v4i16_t*)p)); }
__device__ __forceinline__ float rowmax(const f32x16&p0,const f32x16&p1){
  float a=max3f(p0[0],p0[1],p1[0]),b=max3f(p0[2],p0[3],p1[1]);a=max3f(a,p1[2],p1[3]);
  #pragma unroll
  for(int r=4;r<16;r+=4){a=max3f(a,p0[r],p0[r+1]);b=max3f(b,p0[r+2],p0[r+3]);a=max3f(a,p1[r],p1[r+1]);b=max3f(b,p1[r+2],p1[r+3]);}
  const float m=max2f(a,b);
  auto rr=__builtin_amdgcn_permlane32_swap(__float_as_uint(m),__float_as_uint(m),false,false);
  return max2f(__uint_as_float(rr[0]),__uint_as_float(rr[1]));
}
__device__ __forceinline__ void pv(f32x16*o,int vb,bf16x8 pa0,bf16x8 pa1,bf16x8 pa2,bf16x8 pa3){
  #pragma unroll
  for(int d0=0;d0<2;++d0){s16x4 lo[4],hi[4];
    #pragma unroll
    for(int ks=0;ks<4;++ks){
      asm volatile("ds_read_b64_tr_b16 %0,%1 offset:%c2":"=&v"(lo[ks]):"v"(vb),"i"(d0*4096+ks*1024):"memory");
      asm volatile("ds_read_b64_tr_b16 %0,%1 offset:%c2":"=&v"(hi[ks]):"v"(vb),"i"(d0*4096+ks*1024+512):"memory");}
    asm volatile("s_waitcnt lgkmcnt(0)":::"memory");SBAR();
    #define PK(k) (bf16x8){lo[k][0],lo[k][1],lo[k][2],lo[k][3],hi[k][0],hi[k][1],hi[k][2],hi[k][3]}
    o[d0]=__builtin_amdgcn_mfma_f32_32x32x16_bf16(pa0,PK(0),o[d0],0,0,0);
    o[d0]=__builtin_amdgcn_mfma_f32_32x32x16_bf16(pa1,PK(1),o[d0],0,0,0);
    o[d0]=__builtin_amdgcn_mfma_f32_32x32x16_bf16(pa2,PK(2),o[d0],0,0,0);
    o[d0]=__builtin_amdgcn_mfma_f32_32x32x16_bf16(pa3,PK(3),o[d0],0,0,0);
    #undef PK
  }
}

#ifndef ATTN_STORE16
#define ATTN_STORE16(p,v) (*(u32x4*)(p)=(v))
#endif
template<int THRL> __device__ __forceinline__ void attn_unit(int b,int qcol,int kcol,int vcol,int ocol,int qb,const bf16*__restrict__ PB,bf16*O,char*shm,const int wid){
  const int lane=mk_lane_id(),r32=lane&31,hi=lane>>5;
  const long rowbase=(long)b*SEQ; const int q0=qb*QB;
  const bf16*Qw=PB+(rowbase+q0+wid*QBLK)*DM+qcol;
  const bf16*Kh=PB+rowbase*DM+kcol,*Vh=PB+rowbase*DM+vcol;
  const unsigned lds0=(unsigned)(uintptr_t)shm;
  float*wsf=(float*)(shm+LDS_WS)+wid*64;
  const bf16*ksrc=Kh+(long)lane*DM+wid*8;
  const bf16*vsrc=Vh+(long)(16*(wid&3)+(lane>>2))*DM+(wid>>2)*32+(lane&3)*8;
  const unsigned kdst=lds0+LDS_K+wid*1024, vdst=lds0+LDS_V+wid*1024;
  #define DMA_K(t,slot) glds16(ksrc+(long)(t)*KVBLK*DM,(unsigned)__builtin_amdgcn_readfirstlane(kdst+(slot)))
  #define DMA_V(t,slot) glds16(vsrc+(long)(t)*KVBLK*DM,(unsigned)__builtin_amdgcn_readfirstlane(vdst+(slot)))
  const int vb0=(int)(lds0+LDS_V)+((lane>>4)&1)*32+(lane&3)*8+(4*hi+((lane&15)>>2))*64;
  const char*Kbase=shm+LDS_K; bf16x8 kf[8];
  const lds_cptr shm3=(lds_cptr)shm; const lds_cptr kp0=shm3+LDS_K+hi*1024+r32*16; const lds_cptr vp0=shm3+LDS_V+((lane>>4)&1)*32+(lane&3)*8+(4*hi+((lane&15)>>2))*64;
  const int NT=(q0+QB)/KVBLK;
  DMA_K(0,0);DMA_V(0,0);DMA_K(1,SLOTB);
  bf16x8 qr[4];
  #pragma unroll
  for(int d0=0;d0<4;++d0)qr[d0]=*reinterpret_cast<const bf16x8*>(&Qw[(long)r32*DM+d0*16+hi*8]);
  float mhat=0.f,l_reg=0.f;f32x16 o[2];o[0]=f32x16{};o[1]=f32x16{};f32x16 negm=f32x16{};asm volatile("":"+v"(negm));
  const int qrel=wid*QBLK+r32; const lds_cfptr tabr=(lds_cfptr)(shm3+LDS_TAB); const int cb0=383-q0-qrel+4*hi;
  #define CMASK(P0,P1,t) do{ if((t)>=NT-6) bias_add(P0,P1,tabr,cb0+64*(t)); }while(0)
  bool resc=false;
  #define START(P0,P1) do{ const float rm=rowmax(P0,P1); resc=false; \
    { const float dl=rm; mhat=fadd_s(mhat,dl); \
      _Pragma("unroll") for(int r=0;r<16;++r){P0[r]=fsub_s(P0[r],dl);P1[r]=fsub_s(P1[r],dl);} \
      _Pragma("unroll") for(int r=0;r<16;++r)negm[r]=-mhat; asm volatile("":"+v"(negm)); } \
    _Pragma("unroll") for(int r=0;r<16;++r)P0[r]=__builtin_amdgcn_exp2f(P0[r]); }while(0)
  #define RESC() do{ if(resc){ asm volatile("s_waitcnt lgkmcnt(0)":::"memory"); \
      _Pragma("unroll") for(int d_=0;d_<2;++d_) _Pragma("unroll") for(int r=0;r<16;++r)o[d_][r]*=wsf[crow(r,hi)]; } }while(0)
  f32x16 pA0,pA1,pB0,pB1;
  int sl_prev=0,sl_cur=0,sl_next=SLOTB;
  #define ROT() do{sl_prev=sl_cur;sl_cur=sl_next;sl_next=(sl_next==(NSLOT-1)*SLOTB)?0:sl_next+SLOTB;}while(0)
  DMA_K(2,2*SLOTB);
  WAIT_BAR(3);
  qkt(pA0,pA1,Kbase,qr,negm,r32,hi);asm volatile("s_nop 15\n\ts_nop 7":"+v"(pA0),"+v"(pA1));CMASK(pA0,pA1,0);
  START(pA0,pA1);
  _Pragma("unroll") for(int r=0;r<16;++r)pA1[r]=__builtin_amdgcn_exp2f(pA1[r]);
  WAIT_BAR(0);
  DMA_K(3,0);DMA_V(1,SLOTB);
  ROT();
  kload8(kf,kp0+sl_cur);
  WAIT_BAR(2);
  s16x4 vlo[8],vhi[8]; u32x4 pw0,pw1,pw2,pw3;
  #define PKW(P,B) cvtpk_s(P[B],P[B+1])
  #define PAF(k) __builtin_bit_cast(bf16x8,pw##k)
  #define VFR(i) (bf16x8){vlo[i][0],vlo[i][1],vlo[i][2],vlo[i][3],vhi[i][0],vhi[i][1],vhi[i][2],vhi[i][3]}
  #define PIN(x) asm volatile("":"+v"(x))
  #define MX3(a,b,c) __builtin_fmaxf(__builtin_fmaxf((a),(b)),(c))
  #define GAPA(MF,A0,A1,A2,A3,W0,W1,PW) do{ MF; sacc+=A0; sacc+=A1; sacc+=A2; sacc+=A3; PIN(sacc); W0; W1; PIN(PW); SBAR(); }while(0)
  #define EX(v) __builtin_amdgcn_exp2f(v)
  #define GAPB(MF,X,B) do{ MF; X[B]=EX(X[B]); X[B+1]=EX(X[B+1]); X[B+2]=EX(X[B+2]); X[B+3]=EX(X[B+3]); PIN(X); SBAR(); }while(0)
  #define VRD(i) do{ vlo[i]=vtr(vp_+(((i)>>2)*4096+((i)&3)*1024)); vhi[i]=vtr(vp_+(((i)>>2)*4096+((i)&3)*1024+512)); }while(0)
  #define KRD(G,j) do{ if(G){ kload2(kf,kp0+sl_next,j); SBAR(); } }while(0)
  #define STEP(C0,C1,P0,P1,t,GK,GV,GL) do{ SBAR(); \
    const lds_cptr vp_=vp0+sl_prev; \
    VRD(0); SBAR(); float sacc=(P0[0]+P0[1]); \
    GAPA(C0=__builtin_amdgcn_mfma_f32_32x32x16_bf16(kf[0],qr[0],negm,0,0,0), P0[2],P0[3],P0[4],P0[5],     pw0[0]=PKW(P0,0), pw0[1]=PKW(P0,2), pw0); \
    VRD(4); SBAR(); GAPA(C1=__builtin_amdgcn_mfma_f32_32x32x16_bf16(kf[1],qr[0],negm,0,0,0), P0[6],P0[7],P0[8],P0[9],     pw0[2]=PKW(P0,4), pw0[3]=PKW(P0,6), pw0); \
    VRD(1); SBAR(); GAPA(C0=__builtin_amdgcn_mfma_f32_32x32x16_bf16(kf[2],qr[1],C0,0,0,0),   P0[10],P0[11],P0[12],P0[13], pw1[0]=PKW(P0,8), pw1[1]=PKW(P0,10), pw1); \
    VRD(5); SBAR(); GAPA(C1=__builtin_amdgcn_mfma_f32_32x32x16_bf16(kf[3],qr[1],C1,0,0,0),   P0[14],P0[15],P1[0],P1[1],   pw1[2]=PKW(P0,12),pw1[3]=PKW(P0,14), pw1); \
    VRD(2); SBAR(); GAPA(C0=__builtin_amdgcn_mfma_f32_32x32x16_bf16(kf[4],qr[2],C0,0,0,0),   P1[2],P1[3],P1[4],P1[5],     pw2[0]=PKW(P1,0), pw2[1]=PKW(P1,2), pw2); \
    VRD(6); SBAR(); GAPA(C1=__builtin_amdgcn_mfma_f32_32x32x16_bf16(kf[5],qr[2],C1,0,0,0),   P1[6],P1[7],P1[8],P1[9],     pw2[2]=PKW(P1,4), pw2[3]=PKW(P1,6), pw2); \
    VRD(3); SBAR(); GAPA(C0=__builtin_amdgcn_mfma_f32_32x32x16_bf16(kf[6],qr[3],C0,0,0,0),   P1[10],P1[11],P1[12],P1[13], pw3[0]=PKW(P1,8), pw3[1]=PKW(P1,10), pw3); \
    VRD(7); SBAR(); GAPA(C1=__builtin_amdgcn_mfma_f32_32x32x16_bf16(kf[7],qr[3],C1,0,0,0),   P1[14],P1[15],0.f,0.f,       pw3[2]=PKW(P1,12),pw3[3]=PKW(P1,14), pw3); \
    l_reg+=sacc; \
    if(GK){DMA_K((t)+3,sl_cur);} if(GV){DMA_V((t)+1,sl_next);} \
    CMASK(C0,C1,t); \
    { float a=MX3(C0[0],C0[1],C1[0]),b=MX3(C0[2],C0[3],C1[1]); a=MX3(a,C1[2],C1[3]); \
      _Pragma("unroll") for(int r=4;r<16;r+=4){a=MX3(a,C0[r],C0[r+1]);b=MX3(b,C0[r+2],C0[r+3]);a=MX3(a,C1[r],C1[r+1]);b=MX3(b,C1[r+2],C1[r+3]);} \
      float rm=__builtin_fmaxf(a,b); { auto rr=__builtin_amdgcn_permlane32_swap(__float_as_uint(rm),__float_as_uint(rm),false,false); rm=__builtin_fmaxf(__uint_as_float(rr[0]),__uint_as_float(rr[1])); } \
      resc=false; \
      if(__builtin_expect(__any(rm>(float)THRL),0)){ const float dl=__builtin_fmaxf(rm,0.f); mhat+=dl; \
        _Pragma("unroll") for(int r=0;r<16;++r){C0[r]-=dl;C1[r]-=dl;} \
        _Pragma("unroll") for(int r=0;r<16;++r)negm[r]=-mhat; asm volatile("":"+v"(negm)); \
        const float f=__builtin_amdgcn_exp2f(-dl); l_reg*=f; if(hi==0)wsf[r32]=f; resc=true; } } \
    SBAR(); \
    GAPB(o[0]=__builtin_amdgcn_mfma_f32_32x32x16_bf16(PAF(0),VFR(0),o[0],0,0,0), C0,0); \
    GAPB(o[1]=__builtin_amdgcn_mfma_f32_32x32x16_bf16(PAF(0),VFR(4),o[1],0,0,0), C0,4); \
    KRD(GL,0); GAPB(o[0]=__builtin_amdgcn_mfma_f32_32x32x16_bf16(PAF(1),VFR(1),o[0],0,0,0), C0,8); \
    KRD(GL,1); GAPB(o[1]=__builtin_amdgcn_mfma_f32_32x32x16_bf16(PAF(1),VFR(5),o[1],0,0,0), C0,12); \
    KRD(GL,2); GAPB(o[0]=__builtin_amdgcn_mfma_f32_32x32x16_bf16(PAF(2),VFR(2),o[0],0,0,0), C1,0); \
    KRD(GL,3); GAPB(o[1]=__builtin_amdgcn_mfma_f32_32x32x16_bf16(PAF(2),VFR(6),o[1],0,0,0), C1,4); \
    GAPB(o[0]=__builtin_amdgcn_mfma_f32_32x32x16_bf16(PAF(3),VFR(3),o[0],0,0,0), C1,8); \
    GAPB(o[1]=__builtin_amdgcn_mfma_f32_32x32x16_bf16(PAF(3),VFR(7),o[1],0,0,0), C1,12); \
    }while(0)
  int t=1;
  #undef CMASK
  #define CMASK(P0,P1,t) do{}while(0)
  for(;t+7<NT;t+=2){
    STEP(pB0,pB1,pA0,pA1,t,true,true,true);     WAIT_BAR(2); RESC(); ROT();
    STEP(pA0,pA1,pB0,pB1,t+1,true,true,true);   WAIT_BAR(2); RESC(); ROT();
  }
  #undef CMASK
  #define CMASK(P0,P1,t) do{ if((t)>=NT-6) bias_add(P0,P1,tabr,cb0+64*(t)); }while(0)
  #define ENDW(tt) do{ if((tt)+3<NT){WAIT_BAR(2);} else if((tt)+2<NT){WAIT_BAR(1);} else {WAIT_BAR(0);} }while(0)
  for(;t+1<NT;t+=2){
    STEP(pB0,pB1,pA0,pA1,t,(t+3<NT),(t+1<NT),(t+1<NT));       ENDW(t);   RESC(); ROT();
    STEP(pA0,pA1,pB0,pB1,t+1,(t+4<NT),(t+2<NT),(t+2<NT));     ENDW(t+1); RESC(); ROT();
  }
  STEP(pB0,pB1,pA0,pA1,NT-1,false,false,false); RESC();
  { float sacc=pB0[0]+pB0[1]; _Pragma("unroll") for(int r=2;r<16;++r)sacc+=pB0[r]; _Pragma("unroll") for(int r=0;r<16;++r)sacc+=pB1[r]; l_reg+=sacc;
    pw0=(u32x4){PKW(pB0,0),PKW(pB0,2),PKW(pB0,4),PKW(pB0,6)};pw1=(u32x4){PKW(pB0,8),PKW(pB0,10),PKW(pB0,12),PKW(pB0,14)};pw2=(u32x4){PKW(pB1,0),PKW(pB1,2),PKW(pB1,4),PKW(pB1,6)};pw3=(u32x4){PKW(pB1,8),PKW(pB1,10),PKW(pB1,12),PKW(pB1,14)};
    SBAR(); pv(o,vb0+sl_cur,PAF(0),PAF(1),PAF(2),PAF(3)); }
  #undef PKW
  #undef PAF
  #undef VFR
  #undef PIN
  #undef MX3
  #undef GAPA
  #undef GAPB
  #undef EX
  #undef VRD
  #undef KRD
  #undef STEP
  #undef ENDW
  {auto rr=__builtin_amdgcn_permlane32_swap(__float_as_uint(l_reg),__float_as_uint(l_reg),false,false);l_reg=__uint_as_float(rr[0])+__uint_as_float(rr[1]);}
  if(hi==0)wsf[32+r32]=l_reg;asm volatile("s_waitcnt lgkmcnt(0)":::"memory");
  float rli[16];
  #pragma unroll
  for(int r=0;r<16;++r)rli[r]=__builtin_amdgcn_rcpf(wsf[32+crow(r,hi)]);
  bf16*Ow=O+(rowbase+q0+wid*QBLK)*OPITCH+ocol;
  { bf16*stg=(bf16*)(shm+LDS_OST)+wid*2048;
    #pragma unroll
    for(int r=0;r<16;++r){const int orow=crow(r,hi);
      #pragma unroll
      for(int d0=0;d0<2;++d0)stg[orow*64+d0*32+r32]=__float2bfloat16(o[d0][r]*rli[r]);}
    asm volatile("s_waitcnt lgkmcnt(0)":::"memory");
    #pragma unroll
    for(int i=0;i<4;++i){const int row=i*8+(lane>>3),ch=lane&7; const u32x4 v=*(const u32x4*)(stg+row*64+ch*8); ATTN_STORE16(Ow+(long)row*OPITCH+ch*8,v);} }
  asm volatile("s_waitcnt lgkmcnt(0)\n\ts_barrier":::"memory");
  #undef DMA_K
  #undef DMA_V
  #undef CMASK
  #undef START
  #undef RESC
  #undef ROT
}
constexpr int ATTN_LDS_BYTES=LDS_BYTES;
struct AttnArgs { const bf16* P; bf16* O; const float* tab; };
template<int THRL=8> __device__ __forceinline__ void attn_phase(char*lds,const AttnArgs&T,int vcu,const int wid){
  const int sg=vcu>>1, b=sg>>5, h=(sg>>2)&7, ih=(sg>>1)&1, vh=sg&1, s4=(vcu&1)*4;
  { __attribute__((address_space(3))) float* tl=(__attribute__((address_space(3))) float*)(lds+LDS_TAB); for(int i=wid*64+mk_lane_id();i<TAB_N;i+=512) tl[i]=T.tab[h*TAB_N+i]; }
  asm volatile("s_waitcnt vmcnt(0) lgkmcnt(0)\n\ts_barrier":::"memory");
  const int qcol=2048+h*128+ih*64, kcol=h*128+ih*64, vcol=1024+h*128+vh*64, ocol=h*256+ih*128+vh*64;
  for(int i=0;i<8;++i){ const int j=s4+(i>>1); const int qb=(i&1)?15-j:j; attn_unit<THRL>(b,qcol,kcol,vcol,ocol,qb,T.P,T.O,lds,wid); }
}
#undef SBAR
#undef WAIT_BAR
}

#define GAS __attribute__((address_space(1)))
#define LAS __attribute__((address_space(3)))
typedef unsigned short bf16;
typedef unsigned v4u __attribute__((ext_vector_type(4)));
typedef float f32x4 __attribute__((ext_vector_type(4)));
typedef short bf16x8 __attribute__((ext_vector_type(8)));
typedef GAS unsigned gu32;
typedef GAS unsigned long long gu64;
#define RLX_AGENT __ATOMIC_RELAXED, __HIP_MEMORY_SCOPE_AGENT
#define LDS_WAIT() asm volatile("s_waitcnt lgkmcnt(0)" ::: "memory")
#define VM_WAIT() asm volatile("s_waitcnt vmcnt(0)" ::: "memory")
__device__ __forceinline__ unsigned long long rt() { return __builtin_amdgcn_s_memrealtime(); }
__device__ __forceinline__ unsigned f2bf(float f) { unsigned u = __builtin_bit_cast(unsigned, f); return (u + 0x7fffu + ((u >> 16) & 1u)) >> 16; }
__device__ __forceinline__ unsigned pk2(float lo, float hi) { return f2bf(lo) | (f2bf(hi) << 16); }

#define XB_TMO      128
#define XB_XCNT(j)  (256  + 64 * (j))
#define XB_XSUB(j)  (1280 + 64 * (j))
#define XB_XGEN(j)  (2304 + 64 * (j))
#define XB_TOP      3328
#define XB_TOPGEN   3392
#define XCD_BAR_WORDS 3456
#define XB_SPIN_CAP (1u << 18)

__device__ __forceinline__ unsigned xb_ld(unsigned* p)              { return __hip_atomic_load(p, __ATOMIC_RELAXED, __HIP_MEMORY_SCOPE_AGENT); }
__device__ __forceinline__ unsigned xb_add(unsigned* p, unsigned v) { return __hip_atomic_fetch_add(p, v, __ATOMIC_RELAXED, __HIP_MEMORY_SCOPE_AGENT); }
__device__ __forceinline__ unsigned xb_xcc_id() { return (unsigned)__builtin_amdgcn_s_getreg((3 << 11) | 20) & 0xFu; }
#define XB_SPIN(cond, bar) do { unsigned _sp = 0; while (cond) { __builtin_amdgcn_s_sleep(1); \
    if ((++_sp & 255u) == 0u) { if (xb_ld(&(bar)[XB_TMO])) break; if (_sp > XB_SPIN_CAP) { atomicAdd(&(bar)[XB_TMO], 1u); break; } } } } while (0)

struct XcdBarrier {
    unsigned* bar; unsigned x;
    volatile LAS unsigned* st;
};

__device__ __forceinline__ XcdBarrier xcd_barrier_post(unsigned* bar, volatile LAS unsigned* st, const bool leader) {
    XcdBarrier b; b.bar = bar; b.x = xb_xcc_id(); b.st = st;
    if (leader) (void)xb_add(&bar[XB_XCNT(b.x)], 1u);
    return b;
}
__device__ __forceinline__ void xcd_barrier_complete(unsigned* bar, unsigned x, unsigned& nloc, unsigned& nx) {
    const unsigned G = gridDim.x * gridDim.y * gridDim.z;
    unsigned sum, cnt, mine, sp = 0u;
    for (;;) {
        sum = 0u; cnt = 0u; mine = 0u;
#pragma unroll
        for (unsigned j = 0; j < 16; ++j) { const unsigned c = xb_ld(&bar[XB_XCNT(j)]); sum += c; cnt += (c > 0u) ? 1u : 0u; mine = (j == x) ? c : mine; }
        if (sum == G) break;
        __builtin_amdgcn_s_sleep(1);
        if ((++sp & 255u) == 0u) { if (xb_ld(&bar[XB_TMO])) break; if (sp > XB_SPIN_CAP) { atomicAdd(&bar[XB_TMO], 1u); break; } }
    }
    nloc = mine > 0u ? mine : 1u; nx = cnt > 0u ? cnt : 1u;
}

__device__ __forceinline__ void xcd_barrier(const XcdBarrier& b, const bool leader) {
    asm volatile("s_waitcnt vmcnt(0)" ::: "memory");
    __syncthreads();
    if (leader) {
        unsigned* bar = b.bar;
        __builtin_amdgcn_s_waitcnt(0);
        unsigned nloc = b.st[0], nx = b.st[1];
        if (nloc == 0u) { xcd_barrier_complete(bar, b.x, nloc, nx); b.st[0] = nloc; b.st[1] = nx; }
        const unsigned old = xb_add(&bar[XB_XSUB(b.x)], 1u);
        const unsigned gen = old / nloc;
        if (old + 1u == (gen + 1u) * nloc) {
            __builtin_amdgcn_fence(__ATOMIC_RELEASE, "agent");
            asm volatile("s_waitcnt vmcnt(0)" ::: "memory");
            const unsigned og = xb_add(&bar[XB_TOP], 1u);
            const unsigned tg = og / nx;
            if (og + 1u == (tg + 1u) * nx) xb_add(&bar[XB_TOPGEN], 1u);
            else XB_SPIN(xb_ld(&bar[XB_TOPGEN]) == tg, bar);
            __builtin_amdgcn_fence(__ATOMIC_ACQUIRE, "agent");
            xb_add(&bar[XB_XGEN(b.x)], 1u);
            asm volatile("s_waitcnt vmcnt(0)" ::: "memory");
        } else {
            XB_SPIN(xb_ld(&bar[XB_XGEN(b.x)]) == gen, bar);
            __builtin_amdgcn_fence(__ATOMIC_ACQUIRE, "agent");
            asm volatile("s_waitcnt vmcnt(0)" ::: "memory");
        }
    }
    __syncthreads();
}

constexpr int NWAVES = 8;
constexpr int BATCH = 4, SEQ = 4096, DMODEL = 2048, M = BATCH * SEQ;
constexpr int NP = 6912;
constexpr int PC_K = 0, PC_V = 1024, PC_Q = 2048, PC_R = 3072, PC_KR = 4096, PC_VR = 5120;
constexpr int PC_W1A = 6144, PC_W1B = 6208, PC_A1A = 6272, PC_A1B = 6336, PC_G1A = 6400, PC_G1B = 6560, PC_PAD = 6720;
constexpr int DFF = 5632, NUP = 2 * DFF, KL2 = 384, NL2 = 3072;
constexpr int KS_ADA = 32;
constexpr float NORM_EPS = 1e-6f, GN_EPS = 64e-5f, LOG2E = 1.4426950408889634f;
constexpr float QSCALE = 0.125f * LOG2E;
enum { I_X = 0, I_C, I_RELB, I_WADA, I_BADA, I_NMG, I_WIN, I_QNG, I_KNG, I_LQ1, I_LK1, I_LQ2, I_LK2, I_SUBG, I_MURKV, I_MUWAG, I_W0, I_W1, I_W2, I_A0, I_A1, I_A2, I_G1, I_G2,
       I_KK, I_KA, I_RK, I_LNG, I_LNB, I_WOUT, I_NFG, I_WUP, I_CW, I_CB, I_WDN, N_IN };

constexpr size_t MiB = 1u << 20;
constexpr size_t WS_CTL = 0, CTL_ZERO_BYTES = 64 * 1024;
constexpr size_t WS_MOD = 1 * MiB;
constexpr size_t WS_BIASF = 1 * MiB + 256 * 1024;
constexpr size_t WS_ROWSS = 1 * MiB + 512 * 1024;
constexpr size_t WS_ATAB = 1 * MiB + 640 * 1024;
constexpr size_t WS_LAM = 1 * MiB + 704 * 1024;
constexpr size_t WS_GSF = 1 * MiB + 768 * 1024;
constexpr size_t WS_WDN = 4 * MiB, WS_WUP = 26 * MiB, WS_H = 70 * MiB, WS_WOUT = 134 * MiB, WS_WIN = 142 * MiB, WS_WL2 = 169 * MiB;
constexpr size_t WS_P = 172 * MiB, WS_LA = 388 * MiB, WS_L2 = 400 * MiB, WS_MODP = 496 * MiB;
constexpr size_t WS_OBUF = WS_H, WS_XG = WS_H, WS_UP = 160 * MiB, WS_ACTLO = 26 * MiB, WS_ACTHI = 160 * MiB, WS_END = 512 * MiB;
static_assert(WS_WIN + (size_t)NP * 2048 * 2 <= WS_WL2 && WS_WL2 + (size_t)NL2 * KL2 * 2 <= WS_P && WS_P + (size_t)M * NP * 2 <= WS_LA && WS_LA + (size_t)M * KL2 * 2 <= WS_L2 && WS_L2 + (size_t)M * NL2 * 2 <= WS_MODP, "ws map 1");
static_assert(WS_MODP + (size_t)KS_ADA * 4 * 12288 * 4 <= WS_END && WS_UP + (size_t)M * NUP * 2 <= WS_END && WS_ACTLO + (size_t)(M / 2) * DFF * 2 <= WS_UP && WS_WUP + (size_t)NUP * 2048 * 2 <= WS_H && WS_WDN + (size_t)2048 * DFF * 2 <= WS_WUP, "ws map 2");
constexpr int CW_BAR = 4096;

constexpr int RING_OFF = 0, RING_BYTES = 131072;
constexpr int LDSCTL_OFF = RING_BYTES, MISC_OFF = LDSCTL_OFF + 320;
constexpr int LDS_BYTES = 147456;

struct Frame {
    LAS unsigned char* lds;
    volatile LAS unsigned* MISC;
    gu32* ctl;
    int wave, vcu, G;
    float* out; unsigned char* ws;
};
typedef const float* mk_fptr;
__device__ __forceinline__ const float* inp(int k) {
    const __attribute__((address_space(4))) mk_fptr* t = (const __attribute__((address_space(4))) mk_fptr*)__builtin_amdgcn_kernarg_segment_ptr(); asm volatile("" : "+s"(t));
    return (const float*)(const __attribute__((address_space(1))) float*)t[k];
}
__device__ __forceinline__ float wave_sum(float v) {
#pragma unroll
    for (int o = 1; o < 64; o <<= 1) v += __shfl_xor(v, o);
    return v;
}
__device__ __forceinline__ float bf2f(unsigned short h) { return __uint_as_float((unsigned)h << 16); }
__device__ __forceinline__ float bflo(unsigned w) { return __uint_as_float(w << 16); }
__device__ __forceinline__ float bfhi(unsigned w) { return __uint_as_float(w & 0xffff0000u); }
__device__ __forceinline__ float sigm(float x) { return 1.0f / (1.0f + __expf(-x)); }

__device__ __forceinline__ void transpose_item(const float* W, int ldw, bf16* WT, int ldt, int k0, int n0, int drow0, const float* mu, int smode, LAS float* scr, int lane) {
#pragma unroll 8
    for (int i = 0; i < 32; ++i) { const int kk = 2 * i + (lane >> 5); float v = W[(size_t)(k0 + kk) * ldw + n0 + (lane & 31)];
        if (smode) { const float m = mu[k0 + kk]; v *= (smode == 1) ? (1.0f - m) : m; }
        scr[kk * 33 + (lane & 31)] = v; }
    LDS_WAIT(); asm volatile("" ::: "memory");
    const int c = lane & 7;
#pragma unroll
    for (int j = 0; j < 4; ++j) { const int n = (lane >> 3) + 8 * j; const LAS float* s = scr + (8 * c) * 33 + n;
        v4u o; o.x = pk2(s[0 * 33], s[1 * 33]); o.y = pk2(s[2 * 33], s[3 * 33]); o.z = pk2(s[4 * 33], s[5 * 33]); o.w = pk2(s[6 * 33], s[7 * 33]);
        *(GAS v4u*)(WT + (size_t)(drow0 + n) * ldt + k0 + 8 * c) = o; }
    LDS_WAIT(); asm volatile("" ::: "memory");
}
__device__ __forceinline__ int t5_bucket(int n) {
    if (n < 16) return n;
    int large = 16 + (int)(logf((float)n / 16.0f) / logf(8.0f) * 16.0f);
    return large < 31 ? large : 31;
}
__device__ __forceinline__ void p0_prologue(Frame& F) {
    LAS float* scr = (LAS float*)(F.lds + RING_OFF + F.wave * 16384);
    const int gw = F.vcu * NWAVES + F.wave, NGW = F.G * NWAVES, lane = mk_lane_id();
    bf16* WIN_T = (bf16*)(F.ws + WS_WIN); bf16* WOUT_T = (bf16*)(F.ws + WS_WOUT); bf16* WUP_T = (bf16*)(F.ws + WS_WUP); bf16* WDN_T = (bf16*)(F.ws + WS_WDN); bf16* WL2_T = (bf16*)(F.ws + WS_WL2);
    const float* mu_wag = inp(I_MUWAG);
    {
        float* modp = (float*)(F.ws + WS_MODP); const float* wada = inp(I_WADA); const float* c = inp(I_C);
        for (int it = gw; it < KS_ADA * 48; it += NGW) {
            const int kc = it / 48, cg = it % 48; f32x4 a0 = {0.f, 0.f, 0.f, 0.f}, a1 = a0, a2 = a0, a3 = a0;
            const float* wp = wada + (size_t)(64 * kc) * 12288 + 256 * cg + 4 * lane;
#pragma unroll 8
            for (int k = 0; k < 64; ++k) { const f32x4 w = *(const GAS f32x4*)(wp + (size_t)k * 12288); const int kk = 64 * kc + k;
                const float c0 = c[kk], c1 = c[2048 + kk], c2 = c[4096 + kk], c3 = c[6144 + kk];
                a0 += w * (c0 * sigm(c0)); a1 += w * (c1 * sigm(c1)); a2 += w * (c2 * sigm(c2)); a3 += w * (c3 * sigm(c3)); }
            float* o = modp + (size_t)kc * 4 * 12288 + 256 * cg + 4 * lane;
            *(f32x4*)(o) = a0; *(f32x4*)(o + 12288) = a1; *(f32x4*)(o + 2 * 12288) = a2; *(f32x4*)(o + 3 * 12288) = a3;
        }
    }
    constexpr int I_IN = 32 * 192, I_L = 32 * 2, I_LG = 32 * 5, I_LORA = 4 * I_L + 2 * I_LG, I_OUT = 32 * 64, I_UP = 32 * 352, I_DN = 88 * 64;
    constexpr int NITEMS = I_IN + I_LORA + I_OUT + I_UP + I_DN;
    for (int it = gw; it < NITEMS; it += NGW) {
        int r = it;
        if (r < I_IN) { const int kb = r / 192, nb = r % 192, n0 = 32 * nb, blk = n0 >> 10; const int drow = (blk == 0 ? PC_Q : blk == 1 ? PC_K : blk == 2 ? PC_V : blk * 1024) + (n0 & 1023);
            transpose_item(inp(I_WIN), 6144, WIN_T, 2048, 64 * kb, n0, drow, nullptr, 0, scr, lane); continue; } r -= I_IN;
        if (r < I_LORA) {
            if (r < 2 * I_L) { const int v = r / I_L, q = r % I_L; transpose_item(inp(I_W1), 64, WIN_T, 2048, 64 * (q / 2), 32 * (q % 2), (v ? PC_W1B : PC_W1A) + 32 * (q % 2), mu_wag, 1 + v, scr, lane); continue; } r -= 2 * I_L;
            if (r < 2 * I_L) { const int v = r / I_L, q = r % I_L; transpose_item(inp(I_A1), 64, WIN_T, 2048, 64 * (q / 2), 32 * (q % 2), (v ? PC_A1B : PC_A1A) + 32 * (q % 2), mu_wag + 2048, 1 + v, scr, lane); continue; } r -= 2 * I_L;
            { const int v = r / I_LG, q = r % I_LG; transpose_item(inp(I_G1), 160, WIN_T, 2048, 64 * (q / 5), 32 * (q % 5), (v ? PC_G1B : PC_G1A) + 32 * (q % 5), mu_wag + 4096, 1 + v, scr, lane); continue; }
        } r -= I_LORA;
        if (r < I_OUT) { transpose_item(inp(I_WOUT), 2048, WOUT_T, 2048, 64 * (r / 64), 32 * (r % 64), 32 * (r % 64), nullptr, 0, scr, lane); continue; } r -= I_OUT;
        if (r < I_UP) { transpose_item(inp(I_WUP), NUP, WUP_T, 2048, 64 * (r / 352), 32 * (r % 352), 32 * (r % 352), nullptr, 0, scr, lane); continue; } r -= I_UP;
        transpose_item(inp(I_WDN), 2048, WDN_T, DFF, 64 * (r / 64), 32 * (r % 64), 32 * (r % 64), nullptr, 0, scr, lane);
    }
    const int gt = (F.vcu * NWAVES + F.wave) * 64 + lane, NGT = NGW * 64;
    for (int i = gt; i < (NP - PC_PAD) * 2048 / 8; i += NGT) *(GAS v4u*)(WIN_T + (size_t)PC_PAD * 2048 + (size_t)i * 8) = (v4u){0u, 0u, 0u, 0u};
    const float* w2p = inp(I_W2); const float* a2p = inp(I_A2); const float* g2p = inp(I_G2);
    for (int i = gt; i < NL2 * KL2 / 8; i += NGT) {
        const int n = i / (KL2 / 8), k0 = (i % (KL2 / 8)) * 8, kind = n >> 10, nl = n & 1023; float v[8];
#pragma unroll
        for (int e = 0; e < 8; ++e) { const int k = k0 + e; float x = 0.f;
            if (kind == 0) { if (k < 64) x = w2p[(size_t)k * 1024 + nl]; }
            else if (kind == 1) { if (k >= 64 && k < 128) x = a2p[(size_t)(k - 64) * 1024 + nl]; }
            else { if (k >= 128 && k < 288) x = g2p[(size_t)(k - 128) * 1024 + nl]; }
            v[e] = x; }
        v4u o; o.x = pk2(v[0], v[1]); o.y = pk2(v[2], v[3]); o.z = pk2(v[4], v[5]); o.w = pk2(v[6], v[7]);
        *(GAS v4u*)(WL2_T + (size_t)n * KL2 + k0) = o;
    }
    { float* rowss = (float*)(F.ws + WS_ROWSS); for (int i = gt; i < M; i += NGT) rowss[i] = 0.f; }
    { float* atab = (float*)(F.ws + WS_ATAB); const float* relb = inp(I_RELB);
        for (int i = gt; i < 8 * 640; i += NGT) { const int h = i / 640, j = i % 640, d = 383 - j;
            atab[i] = d < 0 ? -INFINITY : (relb[t5_bucket(d) * 8 + h] - relb[31 * 8 + h]) * LOG2E; } }
    if (gt == 0) { const float* q1 = inp(I_LQ1); const float* k1 = inp(I_LK1); const float* q2 = inp(I_LQ2); const float* k2 = inp(I_LK2); float s1 = 0.f, s2 = 0.f; for (int i = 0; i < 64; ++i) { s1 += q1[i] * k1[i]; s2 += q2[i] * k2[i]; }
        *(float*)(F.ws + WS_LAM) = expf(s1) - expf(s2) + 0.2f; }
}
__device__ __forceinline__ void p0b_mod(Frame& F) {
    const int gt = (F.vcu * NWAVES + F.wave) * 64 + mk_lane_id(), NGT = F.G * NWAVES * 64;
    const float* modp = (const float*)(F.ws + WS_MODP); float* mod = (float*)(F.ws + WS_MOD); float* gsf = (float*)(F.ws + WS_GSF);
    const float* bada = inp(I_BADA); const float* nfg = inp(I_NFG);
    for (int i = gt; i < 4 * 12288; i += NGT) { const int j = i % 12288; float s = bada[j];
#pragma unroll 8
        for (int kc = 0; kc < KS_ADA; ++kc) s += modp[(size_t)kc * 4 * 12288 + i];
        mod[i] = s;
        if (j >= 8192 && j < 10240) gsf[(i / 12288) * 2048 + (j - 8192)] = nfg[j - 8192] * (1.0f + s); }
}
__device__ __forceinline__ void p1_hnorm(Frame& F) {
    const int gw = F.vcu * NWAVES + F.wave, NGW = F.G * NWAVES, lane = mk_lane_id();
    const float* mod = (const float*)(F.ws + WS_MOD); const float* g = inp(I_NMG); const float* xin = inp(I_X); bf16* H = (bf16*)(F.ws + WS_H);
    for (int m = gw; m < M; m += NGW) {
        const int b = m >> 12; const GAS f32x4* xr = (const GAS f32x4*)(xin + (size_t)m * 2048) + lane;
        f32x4 v[8]; float s = 0.f;
#pragma unroll
        for (int j = 0; j < 8; ++j) { v[j] = xr[64 * j]; s += (v[j].x * v[j].x + v[j].y * v[j].y) + (v[j].z * v[j].z + v[j].w * v[j].w); }
        const float rstd = 1.0f / sqrtf(wave_sum(s) * (1.0f / 2048.0f) + NORM_EPS);
        GAS unsigned long long* o8 = (GAS unsigned long long*)(H + (size_t)m * 2048) + lane;
#pragma unroll
        for (int j = 0; j < 8; ++j) { const int c = 4 * lane + 256 * j; const f32x4 gg = *(const f32x4*)(g + c), sc = *(const f32x4*)(mod + (size_t)b * 12288 + 2048 + c), sh = *(const f32x4*)(mod + (size_t)b * 12288 + c);
            const f32x4 y = v[j] * rstd * gg * (sc + 1.0f) + sh;
            o8[64 * j] = (unsigned long long)pk2(y.x, y.y) | ((unsigned long long)pk2(y.z, y.w) << 32); }
    }
}
__device__ __forceinline__ void p3_prep(Frame& F) {
    const int gw = F.vcu * NWAVES + F.wave, NGW = F.G * NWAVES, lane = mk_lane_id();
    bf16* P = (bf16*)(F.ws + WS_P); bf16* LA = (bf16*)(F.ws + WS_LA);
    const float* qg = inp(I_QNG); const float* kg = inp(I_KNG);
    float gq[8], gk[8];
#pragma unroll
    for (int e = 0; e < 8; ++e) { gq[e] = qg[(lane & 7) * 8 + e] * QSCALE; gk[e] = kg[(lane & 7) * 8 + e]; }
    for (int m = gw; m < M; m += NGW) {
        const bool has_prev = (m & (SEQ - 1)) != 0; const bf16* pr = P + (size_t)m * NP; const bf16* pp = pr - NP; bf16* la = LA + (size_t)m * KL2;
#pragma unroll
        for (int i = 0; i < 6; ++i) { const int j = lane + 64 * i; float v = 0.f;
            if (j < 64) { v = bf2f(pr[PC_W1A + j]) + (has_prev ? bf2f(pp[PC_W1B + j]) : 0.f); v = tanhf(v); }
            else if (j < 128) { v = bf2f(pr[PC_A1A + j - 64]) + (has_prev ? bf2f(pp[PC_A1B + j - 64]) : 0.f); }
            else if (j < 288) { v = bf2f(pr[PC_G1A + j - 128]) + (has_prev ? bf2f(pp[PC_G1B + j - 128]) : 0.f); v = sigm(v); }
            la[j] = (bf16)f2bf(v); }
#pragma unroll
        for (int it = 0; it < 4; ++it) { const int e0 = it * 512 + lane * 8; const bool isq = e0 >= 1024; bf16* p = P + (size_t)m * NP + (isq ? PC_Q + e0 - 1024 : PC_K + e0);
            const v4u w = *(const GAS v4u*)p; float x[8] = {bflo(w.x), bfhi(w.x), bflo(w.y), bfhi(w.y), bflo(w.z), bfhi(w.z), bflo(w.w), bfhi(w.w)}; float ss = 0.f;
#pragma unroll
            for (int e = 0; e < 8; ++e) ss += x[e] * x[e];
            ss += __shfl_xor(ss, 1); ss += __shfl_xor(ss, 2); ss += __shfl_xor(ss, 4);
            const float rstd = 1.0f / sqrtf(ss * (1.0f / 64.0f) + NORM_EPS);
#pragma unroll
            for (int e = 0; e < 8; ++e) x[e] = x[e] * rstd * (isq ? gq[e] : gk[e]);
            v4u o; o.x = pk2(x[0], x[1]); o.y = pk2(x[2], x[3]); o.z = pk2(x[4], x[5]); o.w = pk2(x[6], x[7]); *(GAS v4u*)p = o; }
    }
    const bf16* WUP_T = (const bf16*)(F.ws + WS_WUP); const float* mod = (const float*)(F.ws + WS_MOD); float* biasf = (float*)(F.ws + WS_BIASF);
    for (int col = gw; col < NUP; col += NGW) { float a[4] = {0.f, 0.f, 0.f, 0.f};
#pragma unroll
        for (int it = 0; it < 4; ++it) { const int k0 = it * 512 + lane * 8; const v4u w = *(const GAS v4u*)(WUP_T + (size_t)col * 2048 + k0);
            const float x[8] = {bflo(w.x), bfhi(w.x), bflo(w.y), bfhi(w.y), bflo(w.z), bfhi(w.z), bflo(w.w), bfhi(w.w)};
#pragma unroll
            for (int b = 0; b < 4; ++b) { const float* sh = mod + (size_t)b * 12288 + 6144 + k0;
#pragma unroll
                for (int e = 0; e < 8; ++e) a[b] += x[e] * sh[e]; } }
#pragma unroll
        for (int b = 0; b < 4; ++b) { const float s = wave_sum(a[b]); if (lane == 0) biasf[(size_t)b * NUP + col] = s; }
    }
}
template <int CTRL> __device__ __forceinline__ float dpp_add(float x) { const int v = __builtin_amdgcn_update_dpp(0, __float_as_int(x), CTRL, 0xF, 0xF, true); return x + __int_as_float(v); }
__device__ __forceinline__ float red8(float x) { x = dpp_add<0xB1>(x); x = dpp_add<0x4E>(x); x = dpp_add<0x141>(x); return x; }
__device__ __forceinline__ void p5_rwkv_scan(Frame& F) {
    constexpr int TB = 32;
    if (F.vcu >= 64) return;
    const int tid = F.wave * 64 + mk_lane_id(), b = F.vcu >> 4, h = F.vcu & 15;
    LAS float* sW = (LAS float*)(F.lds);
    LAS float* sNK = sW + TB * 64; LAS float* sB = sNK + TB * 64; LAS float* sK = sB + TB * 64; LAS float* sR = sK + TB * 64; LAS float* sV = sR + TB * 64; LAS float* sG = sV + TB * 64; LAS float* sY = sG + TB * 64;
    LAS float* sBon = sY + TB * 64;
    LAS float* sPrevR = sBon + TB;
    bf16* P = (bf16*)(F.ws + WS_P); const bf16* L2 = (const bf16*)(F.ws + WS_L2);
    const int tt = tid >> 4, c4 = (tid & 15) * 4, ch = h * 64 + c4;
    float mur[4], muk[4], muv[4], kkc[4], kac[4], rkc[4], lng[4], lnb[4];
    const float* murkv = inp(I_MURKV); const float* pkk = inp(I_KK); const float* pka = inp(I_KA); const float* prk = inp(I_RK); const float* plng = inp(I_LNG); const float* plnb = inp(I_LNB);
#pragma unroll
    for (int e = 0; e < 4; ++e) { mur[e] = murkv[ch + e]; muk[e] = murkv[1024 + ch + e]; muv[e] = murkv[2048 + ch + e];
        kkc[e] = pkk[ch + e]; kac[e] = pka[ch + e]; rkc[e] = prk[ch + e]; lng[e] = plng[ch + e]; lnb[e] = plnb[ch + e]; }
    const int row = tid >> 3, part = tid & 7;
    float st[8];
#pragma unroll
    for (int e = 0; e < 8; ++e) st[e] = 0.f;
    typedef unsigned u32x2v __attribute__((ext_vector_type(2)));
    for (int blk = 0; blk < SEQ / TB; ++blk) {
        const int s = blk * TB + tt; const size_t m = (size_t)b * SEQ + s;
        {
            const bf16* pr = P + m * NP; const bool hp = s > 0;
            const u32x2v rw = *(const GAS u32x2v*)(pr + PC_R + ch), kw = *(const GAS u32x2v*)(pr + PC_KR + ch), vw = *(const GAS u32x2v*)(pr + PC_VR + ch);
            u32x2v kpw = {0u, 0u}, vpw = {0u, 0u};
            if (hp) { kpw = *(const GAS u32x2v*)(pr - NP + PC_KR + ch); vpw = *(const GAS u32x2v*)(pr - NP + PC_VR + ch); }
            float rprev[4] = {0.f, 0.f, 0.f, 0.f};
            if (hp) { if (tt == 0) { const LAS float* q = sPrevR + ((blk + 1) & 1) * 64 + c4; rprev[0] = q[0]; rprev[1] = q[1]; rprev[2] = q[2]; rprev[3] = q[3]; }
                      else { const u32x2v rpw = *(const GAS u32x2v*)(pr - NP + PC_R + ch); rprev[0] = bflo(rpw.x); rprev[1] = bfhi(rpw.x); rprev[2] = bflo(rpw.y); rprev[3] = bfhi(rpw.y); } }
            const bf16* l2 = L2 + m * NL2;
            const u32x2v lww = *(const GAS u32x2v*)(l2 + ch), aw = *(const GAS u32x2v*)(l2 + 1024 + ch), gw2 = *(const GAS u32x2v*)(l2 + 2048 + ch);
            const float rp[4] = {bflo(rw.x), bfhi(rw.x), bflo(rw.y), bfhi(rw.y)}, kp[4] = {bflo(kw.x), bfhi(kw.x), bflo(kw.y), bfhi(kw.y)}, vp[4] = {bflo(vw.x), bfhi(vw.x), bflo(vw.y), bfhi(vw.y)};
            const float kpp[4] = {bflo(kpw.x), bfhi(kpw.x), bflo(kpw.y), bfhi(kpw.y)}, vpp[4] = {bflo(vpw.x), bfhi(vpw.x), bflo(vpw.y), bfhi(vpw.y)};
            const float lw[4] = {bflo(lww.x), bfhi(lww.x), bflo(lww.y), bfhi(lww.y)}, aa[4] = {bflo(aw.x), bfhi(aw.x), bflo(aw.y), bfhi(aw.y)}, gg[4] = {bflo(gw2.x), bfhi(gw2.x), bflo(gw2.y), bfhi(gw2.y)};
            if (tt == TB - 1) { LAS float* q = sPrevR + (blk & 1) * 64 + c4; q[0] = rp[0]; q[1] = rp[1]; q[2] = rp[2]; q[3] = rp[3]; }
            float r[4], k[4], v[4], kkv[4], ss = 0.f;
#pragma unroll
            for (int e = 0; e < 4; ++e) { r[e] = rp[e] + (rprev[e] - rp[e]) * mur[e]; k[e] = kp[e] + (kpp[e] - kp[e]) * muk[e]; v[e] = vp[e] + (vpp[e] - vp[e]) * muv[e]; kkv[e] = k[e] * kkc[e]; ss += kkv[e] * kkv[e]; }
            ss += __shfl_xor(ss, 1); ss += __shfl_xor(ss, 2); ss += __shfl_xor(ss, 4); ss += __shfl_xor(ss, 8);
            const float inv = 1.0f / fmaxf(sqrtf(ss), 1e-12f); float bon = 0.f;
#pragma unroll
            for (int e = 0; e < 4; ++e) { const float kap = kkv[e] * inv, k2 = k[e] * (1.0f + (aa[e] - 1.0f) * kac[e]);
                sW[tt * 64 + c4 + e] = __expf(lw[e]); sNK[tt * 64 + c4 + e] = -kap; sB[tt * 64 + c4 + e] = kap * aa[e]; sK[tt * 64 + c4 + e] = k2; sR[tt * 64 + c4 + e] = r[e]; sV[tt * 64 + c4 + e] = v[e]; sG[tt * 64 + c4 + e] = gg[e];
                bon += r[e] * k2 * rkc[e]; }
            bon += __shfl_xor(bon, 1); bon += __shfl_xor(bon, 2); bon += __shfl_xor(bon, 4); bon += __shfl_xor(bon, 8);
            if ((tid & 15) == 0) sBon[tt] = bon;
        }
        __syncthreads();
        for (int t = 0; t < TB; ++t) {
            const LAS f32x4* pw = (const LAS f32x4*)(sW + t * 64 + part * 8); const LAS f32x4* pn = (const LAS f32x4*)(sNK + t * 64 + part * 8); const LAS f32x4* pb = (const LAS f32x4*)(sB + t * 64 + part * 8);
            const LAS f32x4* pk = (const LAS f32x4*)(sK + t * 64 + part * 8); const LAS f32x4* prr = (const LAS f32x4*)(sR + t * 64 + part * 8);
            const f32x4 w0 = pw[0], w1 = pw[1], n0 = pn[0], n1 = pn[1], b0 = pb[0], b1 = pb[1], k0 = pk[0], k1 = pk[1], r0 = prr[0], r1 = prr[1]; const float vv = sV[t * 64 + row];
            float sa = 0.f;
#pragma unroll
            for (int e = 0; e < 4; ++e) { sa += st[e] * n0[e]; sa += st[4 + e] * n1[e]; }
            sa = red8(sa);
            float y = 0.f;
#pragma unroll
            for (int e = 0; e < 4; ++e) { st[e] = st[e] * w0[e] + sa * b0[e] + vv * k0[e]; st[4 + e] = st[4 + e] * w1[e] + sa * b1[e] + vv * k1[e]; y += st[e] * r0[e]; y += st[4 + e] * r1[e]; }
            y = red8(y);
            if (part == 0) sY[t * 64 + row] = y;
        }
        __syncthreads();
        {
            float y[4], s1 = 0.f;
#pragma unroll
            for (int e = 0; e < 4; ++e) { y[e] = sY[tt * 64 + c4 + e]; s1 += y[e]; }
            s1 += __shfl_xor(s1, 1); s1 += __shfl_xor(s1, 2); s1 += __shfl_xor(s1, 4); s1 += __shfl_xor(s1, 8);
            const float mu = s1 * (1.0f / 64.0f); float s2 = 0.f;
#pragma unroll
            for (int e = 0; e < 4; ++e) { y[e] -= mu; s2 += y[e] * y[e]; }
            s2 += __shfl_xor(s2, 1); s2 += __shfl_xor(s2, 2); s2 += __shfl_xor(s2, 4); s2 += __shfl_xor(s2, 8);
            const float rs = 1.0f / sqrtf(s2 * (1.0f / 64.0f) + GN_EPS), bon = sBon[tt]; float o[4];
#pragma unroll
            for (int e = 0; e < 4; ++e) o[e] = (y[e] * rs * lng[e] + lnb[e] + bon * sV[tt * 64 + c4 + e]) * sG[tt * 64 + c4 + e];
            u32x2v w; w.x = pk2(o[0], o[1]); w.y = pk2(o[2], o[3]); *(GAS u32x2v*)(P + m * NP + PC_R + ch) = w;
        }
        __syncthreads();
    }
}
__device__ __forceinline__ void p6_combine(Frame& F) {
    const int gw = F.vcu * NWAVES + F.wave, NGW = F.G * NWAVES, lane = mk_lane_id();
    const bf16* OB = (const bf16*)(F.ws + WS_OBUF); bf16* P = (bf16*)(F.ws + WS_P); const float lam = *(const float*)(F.ws + WS_LAM);
    const int h = lane >> 3, sub = lane & 7; float g[16];
    const float* subg = inp(I_SUBG);
#pragma unroll
    for (int e = 0; e < 16; ++e) g[e] = subg[sub * 16 + e] * 0.8f;
    for (int m = gw; m < M; m += NGW) {
        const bf16* o0 = OB + (size_t)m * 2048 + h * 256 + sub * 16; float d[16], ss = 0.f;
#pragma unroll
        for (int q = 0; q < 2; ++q) { const v4u a = *(const GAS v4u*)(o0 + 8 * q), c = *(const GAS v4u*)(o0 + 128 + 8 * q);
            const float x0[8] = {bflo(a.x), bfhi(a.x), bflo(a.y), bfhi(a.y), bflo(a.z), bfhi(a.z), bflo(a.w), bfhi(a.w)}, x1[8] = {bflo(c.x), bfhi(c.x), bflo(c.y), bfhi(c.y), bflo(c.z), bfhi(c.z), bflo(c.w), bfhi(c.w)};
#pragma unroll
            for (int e = 0; e < 8; ++e) { d[8 * q + e] = x0[e] - lam * x1[e]; ss += d[8 * q + e] * d[8 * q + e]; } }
        ss += __shfl_xor(ss, 1); ss += __shfl_xor(ss, 2); ss += __shfl_xor(ss, 4);
        const float rstd = 1.0f / sqrtf(ss * (1.0f / 128.0f) + NORM_EPS);
        bf16* dst = P + (size_t)m * NP + PC_Q + h * 128 + sub * 16;
#pragma unroll
        for (int q = 0; q < 2; ++q) { v4u o; o.x = pk2(d[8 * q] * rstd * g[8 * q], d[8 * q + 1] * rstd * g[8 * q + 1]); o.y = pk2(d[8 * q + 2] * rstd * g[8 * q + 2], d[8 * q + 3] * rstd * g[8 * q + 3]);
            o.z = pk2(d[8 * q + 4] * rstd * g[8 * q + 4], d[8 * q + 5] * rstd * g[8 * q + 5]); o.w = pk2(d[8 * q + 6] * rstd * g[8 * q + 6], d[8 * q + 7] * rstd * g[8 * q + 7]); *(GAS v4u*)(dst + 8 * q) = o; }
    }
}
__device__ __forceinline__ void p9_convglu(Frame& F, int half) {
    const int gt = (F.vcu * NWAVES + F.wave) * 64 + mk_lane_id(), NGT = F.G * NWAVES * 64;
    const bf16* UP = (const bf16*)(F.ws + WS_UP); bf16* ACT = (bf16*)(F.ws + (half ? WS_ACTHI : WS_ACTLO));
    const float* cw = inp(I_CW); const float* cb = inp(I_CB);
    constexpr int RUN = 16, NG = DFF / 8, NRUN = (M / 2) / RUN;
    for (int it = gt; it < NRUN * NG; it += NGT) {
        const int run = it / NG, j0 = (it % NG) * 8; const int m0 = half * (M / 2) + run * RUN;
        float wg[3][8], wv[3][8], bg[8], bv[8];
#pragma unroll
        for (int e = 0; e < 8; ++e) { bg[e] = cb[j0 + e]; bv[e] = cb[DFF + j0 + e];
#pragma unroll
            for (int t = 0; t < 3; ++t) { wg[t][e] = cw[t * NUP + j0 + e]; wv[t][e] = cw[t * NUP + DFF + j0 + e]; } }
        float g1[8], g2[8], v1[8], v2[8];
#pragma unroll
        for (int e = 0; e < 8; ++e) { g1[e] = g2[e] = v1[e] = v2[e] = 0.f; }
        const int s0 = m0 & (SEQ - 1);
        if (s0 >= 1) { const v4u a = *(const GAS v4u*)(UP + (size_t)(m0 - 1) * NUP + j0), c = *(const GAS v4u*)(UP + (size_t)(m0 - 1) * NUP + DFF + j0);
            g1[0] = bflo(a.x); g1[1] = bfhi(a.x); g1[2] = bflo(a.y); g1[3] = bfhi(a.y); g1[4] = bflo(a.z); g1[5] = bfhi(a.z); g1[6] = bflo(a.w); g1[7] = bfhi(a.w);
            v1[0] = bflo(c.x); v1[1] = bfhi(c.x); v1[2] = bflo(c.y); v1[3] = bfhi(c.y); v1[4] = bflo(c.z); v1[5] = bfhi(c.z); v1[6] = bflo(c.w); v1[7] = bfhi(c.w); }
        if (s0 >= 2) { const v4u a = *(const GAS v4u*)(UP + (size_t)(m0 - 2) * NUP + j0), c = *(const GAS v4u*)(UP + (size_t)(m0 - 2) * NUP + DFF + j0);
            g2[0] = bflo(a.x); g2[1] = bfhi(a.x); g2[2] = bflo(a.y); g2[3] = bfhi(a.y); g2[4] = bflo(a.z); g2[5] = bfhi(a.z); g2[6] = bflo(a.w); g2[7] = bfhi(a.w);
            v2[0] = bflo(c.x); v2[1] = bfhi(c.x); v2[2] = bflo(c.y); v2[3] = bfhi(c.y); v2[4] = bflo(c.z); v2[5] = bfhi(c.z); v2[6] = bflo(c.w); v2[7] = bfhi(c.w); }
#pragma unroll 4
        for (int r = 0; r < RUN; ++r) { const int m = m0 + r;
            const v4u a = *(const GAS v4u*)(UP + (size_t)m * NUP + j0), c = *(const GAS v4u*)(UP + (size_t)m * NUP + DFF + j0);
            const float g0[8] = {bflo(a.x), bfhi(a.x), bflo(a.y), bfhi(a.y), bflo(a.z), bfhi(a.z), bflo(a.w), bfhi(a.w)}, v0[8] = {bflo(c.x), bfhi(c.x), bflo(c.y), bfhi(c.y), bflo(c.z), bfhi(c.z), bflo(c.w), bfhi(c.w)};
            float o[8];
#pragma unroll
            for (int e = 0; e < 8; ++e) { const float yg = bg[e] + wg[0][e] * g2[e] + wg[1][e] * g1[e] + wg[2][e] * g0[e], yv = bv[e] + wv[0][e] * v2[e] + wv[1][e] * v1[e] + wv[2][e] * v0[e];
                o[e] = yg * sigm(yg) * yv; g2[e] = g1[e]; g1[e] = g0[e]; v2[e] = v1[e]; v1[e] = v0[e]; }
            v4u w; w.x = pk2(o[0], o[1]); w.y = pk2(o[2], o[3]); w.z = pk2(o[4], o[5]); w.w = pk2(o[6], o[7]);
            *(GAS v4u*)(ACT + (size_t)(m - half * (M / 2)) * DFF + j0) = w; }
    }
}

#ifndef MK_N_LAUNCHES
#define MK_N_LAUNCHES 1
#endif
constexpr int NPHASE = 13;
constexpr int N_LAUNCHES = MK_N_LAUNCHES;
struct Args { const float* in[N_IN]; float* out; unsigned char* ws; int ph_lo, ph_hi; };
__global__ void __launch_bounds__(NWAVES * 64, 2) mk_fwd(Args args) {
    extern __shared__ __attribute__((aligned(16))) unsigned char lds[];
    Frame F;
    F.lds = (LAS unsigned char*)lds;
    F.MISC = (volatile LAS unsigned*)(F.lds + MISC_OFF);
    F.wave = __builtin_amdgcn_readfirstlane((int)threadIdx.x >> 6);
    F.G = gridDim.x; { const int bx = blockIdx.x; F.vcu = (F.G % 8 == 0) ? (bx % 8) * (F.G / 8) + bx / 8 : bx; }
    F.ws = args.ws; F.out = args.out; F.ctl = (gu32*)(args.ws + WS_CTL);
    for (int u = F.wave * 64 + mk_lane_id(); u < (LDS_BYTES - LDSCTL_OFF) / 4; u += NWAVES * 64) ((LAS unsigned*)(F.lds + LDSCTL_OFF))[u] = 0u;
    __syncthreads();
    XcdBarrier bar; bar.bar = (unsigned*)(F.ctl + CW_BAR); bar.x = 0; bar.st = nullptr;
    if (N_LAUNCHES == 1) bar = xcd_barrier_post((unsigned*)(F.ctl + CW_BAR), F.MISC + 8, F.wave == 0 && mk_lane_id() == 0);
    const int lo = args.ph_lo, hi = args.ph_hi;
#define IN(k) (lo <= (k) && (k) < hi)
#define SEAM(k) do { if (IN(k) && IN((k) + 1)) xcd_barrier(bar, F.wave == 0 && mk_lane_id() == 0); } while (0)
    unsigned char* ws = args.ws;
    bf16* H = (bf16*)(ws + WS_H); bf16* P = (bf16*)(ws + WS_P); bf16* LA = (bf16*)(ws + WS_LA); bf16* L2 = (bf16*)(ws + WS_L2);
    float* mod = (float*)(ws + WS_MOD);

    if (IN(0)) { p0_prologue(F); } SEAM(0);
    if (IN(1)) { p0b_mod(F); } SEAM(1);
    if (IN(2)) { p1_hnorm(F); } SEAM(2);
    if (IN(3)) {
        pg8::Gemm g{H, H, 1 << 30, 2048, (const bf16*)(ws + WS_WIN), M, NP, 2048}; pg8::StaticOrder S; S.init(M, NP, F.G, (int)blockIdx.x);
        pg8::EpiStore E{P, NP};
        pg8::gemm_phase<pg8::EpiStore, pg8::StaticOrder, true, true>(F.lds + RING_OFF, g, S, E, F.wave);
    } SEAM(3);
    if (IN(4)) { p3_prep(F); } SEAM(4);
    if (IN(5)) {
        int kl2 = KL2; asm volatile("" : "+s"(kl2));
        pg8::Gemm g{LA, LA, 1 << 30, kl2, (const bf16*)(ws + WS_WL2), M, NL2, kl2}; pg8::StaticOrder S; S.init(M, NL2, F.G, (int)blockIdx.x);
        pg8::EpiLora2 E{L2, inp(I_W0), inp(I_A0)};
        pg8::gemm_phase<pg8::EpiLora2, pg8::StaticOrder, true, true>(F.lds + RING_OFF, g, S, E, F.wave);
    } SEAM(5);
    if (IN(6)) {
        const attn_body::AttnArgs AT{(const attn_body::bf16*)P, (attn_body::bf16*)(ws + WS_OBUF), (const float*)(ws + WS_ATAB)};
        attn_body::attn_phase<8>((char*)lds + RING_OFF, AT, F.vcu, F.wave);
        p5_rwkv_scan(F);
    } SEAM(6);
    if (IN(7)) { p6_combine(F); } SEAM(7);
    if (IN(8)) {
        pg8::Gemm g{P + PC_Q, P + PC_Q, 1 << 30, NP, (const bf16*)(ws + WS_WOUT), M, 2048, 2048}; pg8::StaticOrder S; S.init(M, 2048, F.G, (int)blockIdx.x);
        pg8::EpiOut E{inp(I_X), F.out, (bf16*)(ws + WS_XG), (float*)(ws + WS_ROWSS), mod + 4096, (const float*)(ws + WS_GSF), 12288};
        pg8::gemm_phase<pg8::EpiOut, pg8::StaticOrder, true, true>(F.lds + RING_OFF, g, S, E, F.wave);
    } SEAM(8);
    if (IN(9)) {
        const bf16* XG = (const bf16*)(ws + WS_XG);
        pg8::Gemm g{XG, XG, 1 << 30, 2048, (const bf16*)(ws + WS_WUP), M, NUP, 2048}; pg8::StaticOrder S; S.init(M, NUP, F.G, (int)blockIdx.x);
        pg8::EpiUp E{(bf16*)(ws + WS_UP), NUP, (const float*)(ws + WS_ROWSS), (const float*)(ws + WS_BIASF)};
        pg8::gemm_phase<pg8::EpiUp, pg8::StaticOrder, true, true>(F.lds + RING_OFF, g, S, E, F.wave);
    } SEAM(9);
    if (IN(10)) { p9_convglu(F, 0); } SEAM(10);
    if (IN(11)) { p9_convglu(F, 1); } SEAM(11);
    if (IN(12)) {
        pg8::Gemm g{(const bf16*)(ws + WS_ACTLO), (const bf16*)(ws + WS_ACTHI), 32, DFF, (const bf16*)(ws + WS_WDN), M, 2048, DFF}; pg8::StaticOrder S; S.init(M, 2048, F.G, (int)blockIdx.x);
        pg8::EpiDown E{F.out, mod + 10240, 12288};
        pg8::gemm_phase<pg8::EpiDown, pg8::StaticOrder, true, true>(F.lds + RING_OFF, g, S, E, F.wave);
    }
#undef IN
#undef SEAM
}

extern "C" void kernel_launch(void* const* d_in, const int* in_sizes, int n_in, void* d_out, int out_size, void* d_ws, size_t ws_size, hipStream_t stream) {
    static int grid = 0;
    if (grid == 0) {
        if (n_in != N_IN || in_sizes[0] != M * DMODEL || out_size != M * DMODEL || ws_size < WS_END) {
            fprintf(stderr, "kernel_launch: shape/workspace mismatch: n_in %d in0 %d out %d ws %zu (need %zu); nothing launched\n", n_in, n_in > 0 ? in_sizes[0] : -1, out_size, ws_size, (size_t)WS_END); grid = -1; return; }
        int dev = 0, cus = 0, per_cu = 0;
        if (hipGetDevice(&dev) != hipSuccess || hipDeviceGetAttribute(&cus, hipDeviceAttributeMultiprocessorCount, dev) != hipSuccess) { fprintf(stderr, "kernel_launch: device query failed\n"); grid = -1; return; }
        if (hipFuncSetAttribute((const void*)mk_fwd, hipFuncAttributeMaxDynamicSharedMemorySize, LDS_BYTES) != hipSuccess) { fprintf(stderr, "kernel_launch: hipFuncSetAttribute failed\n"); grid = -1; return; }
        if (hipOccupancyMaxActiveBlocksPerMultiprocessor(&per_cu, (const void*)mk_fwd, NWAVES * 64, LDS_BYTES) != hipSuccess || per_cu < 1) { fprintf(stderr, "kernel_launch: occupancy query says %d blocks per CU\n", per_cu); per_cu = 1; }
        (void)hipGetLastError();
        grid = cus;
        if (grid % 8 != 0 || grid < 64) fprintf(stderr, "kernel_launch: unexpected CU count %d\n", grid);
    }
    if (grid < 0) return;
    (void)hipMemsetAsync((char*)d_ws + WS_CTL, 0, CTL_ZERO_BYTES, stream);
    Args a{};
    for (int i = 0; i < N_IN; ++i) a.in[i] = (const float*)d_in[i];
    a.out = (float*)d_out; a.ws = (unsigned char*)d_ws;
    if (N_LAUNCHES == 1) { a.ph_lo = 0; a.ph_hi = NPHASE; hipLaunchKernelGGL(mk_fwd, dim3(grid), dim3(NWAVES * 64), LDS_BYTES, stream, a); }
    else for (int li = 0; li < NPHASE; ++li) { a.ph_lo = li; a.ph_hi = li + 1; hipLaunchKernelGGL(mk_fwd, dim3(grid), dim3(NWAVES * 64), LDS_BYTES, stream, a); }
    const hipError_t le = hipPeekAtLastError();
    if (le != hipSuccess) fprintf(stderr, "kernel_launch: launch failed: %s\n", hipGetErrorName(le));
}
```

```cpp
#include <hip/hip_runtime.h>
#include <hip/hip_bf16.h>
#include <cstdio>
#include <cstdint>
#include <cmath>
__device__ __forceinline__ int mk_lane_id() { int l; asm volatile("v_mbcnt_lo_u32_b32 %0, -1, 0\n\tv_mbcnt_hi_u32_b32 %0, -1, %0" : "=v"(l)); return l; }
namespace pg8 {
#define PG8_LAS __attribute__((address_space(3)))
typedef unsigned short bf16_t;
typedef short bf16x8 __attribute__((ext_vector_type(8)));
typedef float f32x4 __attribute__((ext_vector_type(4)));
typedef unsigned u32x4 __attribute__((ext_vector_type(4)));
constexpr int BM = 256, BK = 64, HALF = 128, HTB = HALF * BK * 2  , STAGE_BYTES = 8 * HTB, NXCD = 8, WGM = 8;

__host__ __device__ __forceinline__ int lds_byte(int r, int c) { const int st = (r >> 4) * 2 + (c >> 5), rr = r & 15, cc = c & 31, ob = rr * 64 + cc * 2; return st * 1024 + (ob ^ (((ob >> 9) & 1) << 5)); }
__host__ __device__ __forceinline__ void stage_rc(int b, int& R, int& C) { const int st = b / 1024, sb = b % 1024, swz = sb ^ (((sb >> 9) & 1) << 5); R = (st >> 1) * 16 + swz / 64; C = (st & 1) * 32 + (swz % 64) / 2; }
__host__ __device__ __forceinline__ int perm32(int rho) { const int n = rho >> 4, i = rho & 15; return 8 * (i >> 2) + 4 * n + (i & 3); }

struct Unit { int pm, pn; };
struct Gemm { const bf16_t* A; const bf16_t* A1; int pm_split; int lda; const bf16_t* Bt; int M, N, K; int ldb = 0; int koff_pn = 1 << 30; int koff = 0; int K2 = 0; };

struct StaticOrder {
    int nM, nN, nwg, G, c;
    __host__ __device__ void init(int M, int N, int G_, int c_) { nM = M / BM; nN = N / BM; nwg = nM * nN; G = G_; c = c_; }
    __host__ __device__ bool next(int i, Unit& u) const {
        const long L = (long)i * G + c; if (L >= nwg) return false;
        int wgid = (int)L; { const int q = nwg / NXCD, r = nwg % NXCD, xcd = wgid % NXCD, off = wgid / NXCD; wgid = (xcd < r ? xcd * (q + 1) : r * (q + 1) + (xcd - r) * q) + off; }
        const int nig = WGM * nN, gid = wgid / nig, fm = gid * WGM, gsz = (nM - fm) < WGM ? (nM - fm) : WGM;
        u.pm = fm + ((wgid % nig) % gsz); u.pn = (wgid % nig) / gsz; return true;
    }
    __device__ __forceinline__ void a_ready(const Unit&) const {}
    __device__ __forceinline__ void done(const Unit&) const {}
};

__device__ __forceinline__ unsigned cvt_pk_bf16(float lo, float hi) { unsigned r; asm volatile("v_cvt_pk_bf16_f32 %0, %1, %2" : "=v"(r) : "v"(lo), "v"(hi)); return r; }
typedef float f32x2 __attribute__((ext_vector_type(2)));
__device__ __forceinline__ float sigmoidf_fast(float x) { return __builtin_amdgcn_rcpf(1.0f + __builtin_amdgcn_exp2f(-1.4426950408889634f * x)); }
__device__ __forceinline__ u32x4 pack8(const f32x4 v0, const f32x4 v1) { u32x4 w; w.x = cvt_pk_bf16(v0[0], v0[1]); w.y = cvt_pk_bf16(v0[2], v0[3]); w.z = cvt_pk_bf16(v1[0], v1[1]); w.w = cvt_pk_bf16(v1[2], v1[3]); return w; }

struct EpiStore {
    static constexpr bool PERM = true, AFTER_DRAIN = false, ROWPERM = false;
    bf16_t* O; int ldc;
    __device__ __forceinline__ void operator()(const f32x4 (&acc)[2][2][4][2], const Unit& u, int wr, int wc, int fr, int fq) const {
        const int row0 = u.pm * BM + wr * 64 + fr, col0 = u.pn * BM + wc * 32 + 8 * fq;
#pragma unroll
        for (int ai = 0; ai < 2; ++ai)
#pragma unroll
            for (int m = 0; m < 4; ++m) { bf16_t* rowp = O + (size_t)(row0 + ai * HALF + m * 16) * ldc + col0;
#pragma unroll
                for (int bj = 0; bj < 2; ++bj) *(u32x4*)(rowp + bj * HALF) = pack8(acc[ai][bj][m][0], acc[ai][bj][m][1]); }
    }
};
struct EpiStoreQK {
    static constexpr bool PERM = true, AFTER_DRAIN = false, ROWPERM = false;
    bf16_t* O; int ldc; const float* qg; const float* kg; float qscale;
    __device__ __forceinline__ void operator()(const f32x4 (&acc)[2][2][4][2], const Unit& u, int wr, int wc, int fr, int fq) const {
        const int row0 = u.pm * BM + wr * 64 + fr;
        const bool isk = u.pn < 4, isq = u.pn >= 8 && u.pn < 12;
        if (!(isk || isq)) {
            const int col0 = u.pn * BM + wc * 32 + 8 * fq;
#pragma unroll
            for (int ai = 0; ai < 2; ++ai)
#pragma unroll
                for (int m = 0; m < 4; ++m) { bf16_t* rowp = O + (size_t)(row0 + ai * HALF + m * 16) * ldc + col0;
#pragma unroll
                    for (int bj = 0; bj < 2; ++bj) *(u32x4*)(rowp + bj * HALF) = pack8(acc[ai][bj][m][0], acc[ai][bj][m][1]); }
            return;
        }
        const float* gp = isq ? qg : kg; const float sc = isq ? qscale : 1.0f;
        f32x4 gv[2][2];
#pragma unroll
        for (int bj = 0; bj < 2; ++bj)
#pragma unroll
            for (int n = 0; n < 2; ++n) gv[bj][n] = *(const f32x4*)(gp + 32 * bj + 8 * fq + 4 * n) * sc;
        const int col0 = u.pn * BM + 64 * wc + 8 * fq;
#pragma unroll
        for (int ai = 0; ai < 2; ++ai)
#pragma unroll
            for (int m = 0; m < 4; ++m) { float ss = 0.f;
#pragma unroll
                for (int bj = 0; bj < 2; ++bj)
#pragma unroll
                    for (int n = 0; n < 2; ++n) { const f32x4 v = acc[ai][bj][m][n]; ss += (v[0] * v[0] + v[1] * v[1]) + (v[2] * v[2] + v[3] * v[3]); }
                ss += __shfl_xor(ss, 16); ss += __shfl_xor(ss, 32);
                const float rs = __builtin_amdgcn_rsqf(ss * (1.0f / 64.0f) + 1e-6f);
                bf16_t* rowp = O + (size_t)(row0 + ai * HALF + m * 16) * ldc + col0;
#pragma unroll
                for (int bj = 0; bj < 2; ++bj) *(u32x4*)(rowp + 32 * bj) = pack8(acc[ai][bj][m][0] * rs * gv[bj][0], acc[ai][bj][m][1] * rs * gv[bj][1]); }
    }
};
struct EpiLora2 {
    static constexpr bool PERM = true, AFTER_DRAIN = false, ROWPERM = false;
    bf16_t* O; const float* w0; const float* a0;
    __device__ __forceinline__ void operator()(const f32x4 (&acc)[2][2][4][2], const Unit& u, int wr, int wc, int fr, int fq) const {
        const int row0 = u.pm * BM + wr * 64 + fr, col0 = u.pn * BM + wc * 32 + 8 * fq, kind = u.pn >> 2, cl = col0 & 1023;
        f32x4 bv[2][2];
#pragma unroll
        for (int bj = 0; bj < 2; ++bj)
#pragma unroll
            for (int n = 0; n < 2; ++n) bv[bj][n] = kind == 0 ? *(const f32x4*)(w0 + cl + bj * HALF + 4 * n) : kind == 1 ? *(const f32x4*)(a0 + cl + bj * HALF + 4 * n) : (f32x4){0.f, 0.f, 0.f, 0.f};
#pragma unroll
        for (int ai = 0; ai < 2; ++ai)
#pragma unroll
            for (int m = 0; m < 4; ++m) { bf16_t* rowp = O + (size_t)(row0 + ai * HALF + m * 16) * 3072 + col0;
#pragma unroll
                for (int bj = 0; bj < 2; ++bj) { f32x4 v0 = acc[ai][bj][m][0] + bv[bj][0], v1 = acc[ai][bj][m][1] + bv[bj][1];
                    if (kind < 2) { const float sc = kind == 0 ? -0.6065306597126334f : 1.0f;
#pragma unroll
                        for (int e = 0; e < 4; ++e) { v0[e] = sc * sigmoidf_fast(v0[e]); v1[e] = sc * sigmoidf_fast(v1[e]); } }
                    *(u32x4*)(rowp + bj * HALF) = pack8(v0, v1); } }
    }
};
struct EpiUp {
    static constexpr bool PERM = true, AFTER_DRAIN = false, ROWPERM = false;
    bf16_t* O; int ldc; const float* rowss; const float* biasf;
    __device__ __forceinline__ void operator()(const f32x4 (&acc)[2][2][4][2], const Unit& u, int wr, int wc, int fr, int fq) const {
        const int row0 = u.pm * BM + wr * 64 + fr, col0 = u.pn * BM + wc * 32 + 8 * fq, b = u.pm >> 4;
        f32x4 bv[2][2];
#pragma unroll
        for (int bj = 0; bj < 2; ++bj)
#pragma unroll
            for (int n = 0; n < 2; ++n) bv[bj][n] = *(const f32x4*)(biasf + (size_t)b * ldc + col0 + bj * HALF + 4 * n);
#pragma unroll
        for (int ai = 0; ai < 2; ++ai)
#pragma unroll
            for (int m = 0; m < 4; ++m) { const int row = row0 + ai * HALF + m * 16; const float rs = __builtin_amdgcn_rsqf(rowss[row] * (1.0f / 2048.0f) + 1e-6f);
                bf16_t* rowp = O + (size_t)row * ldc + col0;
#pragma unroll
                for (int bj = 0; bj < 2; ++bj) *(u32x4*)(rowp + bj * HALF) = pack8(acc[ai][bj][m][0] * rs + bv[bj][0], acc[ai][bj][m][1] * rs + bv[bj][1]); }
    }
};
struct EpiOut {
    static constexpr bool PERM = false, AFTER_DRAIN = false, ROWPERM = false;
    const float* x; bf16_t* x1b; bf16_t* XG; float* rowss; const float* gate; const float* gs;
    int gstride;
    __device__ __forceinline__ void operator()(const f32x4 (&acc)[2][2][4][2], const Unit& u, int wr, int wc, int fr, int fq) const {
        typedef unsigned u32x2v __attribute__((ext_vector_type(2)));
        const int row0 = u.pm * BM + wr * 64 + fr, col0 = u.pn * BM + wc * 32 + 4 * fq, b = u.pm >> 4;
        f32x4 gv[2][2], sv[2][2];
#pragma unroll
        for (int bj = 0; bj < 2; ++bj)
#pragma unroll
            for (int n = 0; n < 2; ++n) { gv[bj][n] = *(const f32x4*)(gate + (size_t)b * gstride + col0 + bj * HALF + n * 16); sv[bj][n] = *(const f32x4*)(gs + (size_t)b * 2048 + col0 + bj * HALF + n * 16); }
        f32x4 xa[4], xb[4], xc[4], xd[4], xe[4];
#define EPO_LOAD(G, XV) { const int ai_ = (G) >> 2, m_ = (G) & 3; const size_t off_ = (size_t)(row0 + ai_ * HALF + m_ * 16) * 2048 + col0; \
            _Pragma("unroll") for (int bj_ = 0; bj_ < 2; ++bj_) _Pragma("unroll") for (int n_ = 0; n_ < 2; ++n_) XV[bj_ * 2 + n_] = *(const f32x4*)(x + off_ + bj_ * HALF + n_ * 16); }
#define EPO_DO(G, XV) { const int ai = (G) >> 2, m = (G) & 3; const int row = row0 + ai * HALF + m * 16; const size_t off = (size_t)row * 2048 + col0; float ss = 0.f; \
            _Pragma("unroll") for (int bj = 0; bj < 2; ++bj) _Pragma("unroll") for (int n = 0; n < 2; ++n) { const f32x4 x1 = XV[bj * 2 + n] + gv[bj][n] * acc[ai][bj][m][n]; \
                { u32x2v wx; wx.x = cvt_pk_bf16(x1[0], x1[1]); wx.y = cvt_pk_bf16(x1[2], x1[3]); *(u32x2v*)(x1b + off + bj * HALF + n * 16) = wx; } ss += (x1[0] * x1[0] + x1[1] * x1[1]) + (x1[2] * x1[2] + x1[3] * x1[3]); \
                const f32x4 g4 = x1 * sv[bj][n]; u32x2v w; w.x = cvt_pk_bf16(g4[0], g4[1]); w.y = cvt_pk_bf16(g4[2], g4[3]); *(u32x2v*)(XG + off + bj * HALF + n * 16) = w; } \
            ss += __shfl_xor(ss, 16); ss += __shfl_xor(ss, 32); if (fq == 0) atomicAdd(rowss + row, ss); }
        EPO_LOAD(0, xa); EPO_LOAD(1, xb); EPO_LOAD(2, xc); EPO_DO(0, xa); EPO_DO(1, xb); EPO_DO(2, xc); EPO_LOAD(3, xa); EPO_LOAD(4, xb); EPO_LOAD(5, xc); EPO_LOAD(6, xd); EPO_LOAD(7, xe); EPO_DO(3, xa); EPO_DO(4, xb); EPO_DO(5, xc); EPO_DO(6, xd); EPO_DO(7, xe);
#undef EPO_LOAD
#undef EPO_DO
    }
};
struct EpiDown {
    static constexpr bool PERM = false, AFTER_DRAIN = false, ROWPERM = false;
    float* out; const bf16_t* x1b; const float* gate; int gstride;
    __device__ __forceinline__ void operator()(const f32x4 (&acc)[2][2][4][2], const Unit& u, int wr, int wc, int fr, int fq) const {
        const int row0 = u.pm * BM + wr * 64 + fr, col0 = u.pn * BM + wc * 32 + 4 * fq, b = u.pm >> 4;
        f32x4 gv[2][2];
#pragma unroll
        for (int bj = 0; bj < 2; ++bj)
#pragma unroll
            for (int n = 0; n < 2; ++n) gv[bj][n] = *(const f32x4*)(gate + (size_t)b * gstride + col0 + bj * HALF + n * 16);
        typedef unsigned u32x2d __attribute__((ext_vector_type(2)));
        u32x2d xa[4], xb[4], xc[4], xd[4], xe[4], xf[4], xg[4], xh[4];
#define EPD_LOAD(G, XV) { const int ai_ = (G) >> 2, m_ = (G) & 3; const size_t off_ = (size_t)(row0 + ai_ * HALF + m_ * 16) * 2048 + col0; \
            _Pragma("unroll") for (int bj_ = 0; bj_ < 2; ++bj_) _Pragma("unroll") for (int n_ = 0; n_ < 2; ++n_) XV[bj_ * 2 + n_] = *(const u32x2d*)(x1b + off_ + bj_ * HALF + n_ * 16); }
#define EPD_DO(G, XV) { const int ai = (G) >> 2, m = (G) & 3; const size_t off = (size_t)(row0 + ai * HALF + m * 16) * 2048 + col0; \
            _Pragma("unroll") for (int bj = 0; bj < 2; ++bj) _Pragma("unroll") for (int n = 0; n < 2; ++n) { const u32x2d w_ = XV[bj * 2 + n]; const f32x4 x1_ = {__uint_as_float(w_.x << 16), __uint_as_float(w_.x & 0xffff0000u), __uint_as_float(w_.y << 16), __uint_as_float(w_.y & 0xffff0000u)}; \
                *(f32x4*)(out + off + bj * HALF + n * 16) = x1_ + gv[bj][n] * acc[ai][bj][m][n]; } }
        EPD_LOAD(0, xa); EPD_LOAD(1, xb); EPD_LOAD(2, xc); EPD_LOAD(3, xd); EPD_LOAD(4, xe); EPD_LOAD(5, xf); EPD_LOAD(6, xg); EPD_LOAD(7, xh); EPD_DO(0, xa); EPD_DO(1, xb); EPD_DO(2, xc); EPD_DO(3, xd); EPD_DO(4, xe); EPD_DO(5, xf); EPD_DO(6, xg); EPD_DO(7, xh);
#undef EPD_LOAD
#undef EPD_DO
    }
};

struct EpiUpGlu {
    static constexpr bool PERM = true, AFTER_DRAIN = false, ROWPERM = true;
    bf16_t* ACT; const float* rowss; const float* biasf; const float* cw; const float* cb; float* uph; float* halo;
    static __device__ __forceinline__ float shr1(float x) { return __int_as_float(__builtin_amdgcn_update_dpp(0, __float_as_int(x), 0x111, 0xF, 0xF, true)); }
    __device__ __forceinline__ void operator()(const f32x4 (&acc)[2][2][4][2], const Unit& u, int wr, int wc, int fr, int fq) const {
        const int T0 = u.pm * BM + 8 * (16 * wr + fr), b = u.pm >> 4, jb = 128 * u.pn + 32 * wc + 8 * fq, blk = 2 * u.pm + wr;
        float rs[8];
#pragma unroll
        for (int k = 0; k < 8; ++k) rs[k] = __builtin_amdgcn_rsqf(rowss[T0 + k] * (1.0f / 2048.0f) + 1e-6f);
        unsigned pkd[8][4];
#pragma unroll
        for (int n = 0; n < 2; ++n) { const int cg = jb + 4 * n, cv = 5632 + cg;
            const f32x4 bg = *(const f32x4*)(biasf + (size_t)b * 11264 + cg), bv = *(const f32x4*)(biasf + (size_t)b * 11264 + cv), cbg = *(const f32x4*)(cb + cg), cbv = *(const f32x4*)(cb + cv);
            const f32x4 g0 = *(const f32x4*)(cw + cg), g1 = *(const f32x4*)(cw + 11264 + cg), g2 = *(const f32x4*)(cw + 22528 + cg), v0 = *(const f32x4*)(cw + cv), v1 = *(const f32x4*)(cw + 11264 + cv), v2 = *(const f32x4*)(cw + 22528 + cv);
            float a8[8][4];
            typedef float f2_ __attribute__((ext_vector_type(2)));
#pragma unroll
            for (int ep = 0; ep < 2; ++ep) { f2_ ug[8], uv[8];
                const f2_ bg2 = {bg[2 * ep], bg[2 * ep + 1]}, bv2 = {bv[2 * ep], bv[2 * ep + 1]}, cbg2 = {cbg[2 * ep], cbg[2 * ep + 1]}, cbv2 = {cbv[2 * ep], cbv[2 * ep + 1]};
                const f2_ g02 = {g0[2 * ep], g0[2 * ep + 1]}, g12 = {g1[2 * ep], g1[2 * ep + 1]}, g22 = {g2[2 * ep], g2[2 * ep + 1]}, v02 = {v0[2 * ep], v0[2 * ep + 1]}, v12 = {v1[2 * ep], v1[2 * ep + 1]}, v22 = {v2[2 * ep], v2[2 * ep + 1]};
#pragma unroll
                for (int k = 0; k < 8; ++k) { const f32x4 ag = acc[k >> 2][0][k & 3][n], av = acc[k >> 2][1][k & 3][n]; const f2_ ag2 = {ag[2 * ep], ag[2 * ep + 1]}, av2 = {av[2 * ep], av[2 * ep + 1]};
                    ug[k] = ag2 * rs[k] + bg2; uv[k] = av2 * rs[k] + bv2; }
                const f2_ hg1 = {shr1(ug[7][0]), shr1(ug[7][1])}, hg2 = {shr1(ug[6][0]), shr1(ug[6][1])}, hv1 = {shr1(uv[7][0]), shr1(uv[7][1])}, hv2 = {shr1(uv[6][0]), shr1(uv[6][1])};
                if (fr == 0) { float* p = uph + (size_t)(blk * 2) * 11264 + 2 * ep; *(f2_*)(p + cg) = ug[0]; *(f2_*)(p + 11264 + cg) = ug[1]; *(f2_*)(p + cv) = uv[0]; *(f2_*)(p + 11264 + cv) = uv[1]; }
                if (fr == 15) { float* p = halo + (size_t)(blk * 2) * 11264 + 2 * ep; *(f2_*)(p + cg) = ug[6]; *(f2_*)(p + 11264 + cg) = ug[7]; *(f2_*)(p + cv) = uv[6]; *(f2_*)(p + 11264 + cv) = uv[7]; }
#pragma unroll
                for (int k = 0; k < 8; ++k) { const f2_ pg1 = k >= 1 ? ug[k - 1] : hg1, pg2 = k >= 2 ? ug[k - 2] : (k == 1 ? hg1 : hg2), pv1 = k >= 1 ? uv[k - 1] : hv1, pv2 = k >= 2 ? uv[k - 2] : (k == 1 ? hv1 : hv2);
                    const f2_ yg = cbg2 + g02 * pg2 + g12 * pg1 + g22 * ug[k], yv = cbv2 + v02 * pv2 + v12 * pv1 + v22 * uv[k];
                    const f2_ sg = {sigmoidf_fast(yg[0]), sigmoidf_fast(yg[1])}; const f2_ a2 = yg * sg * yv;
                    a8[k][2 * ep] = a2[0]; a8[k][2 * ep + 1] = a2[1]; } }
#pragma unroll
            for (int k = 0; k < 8; ++k) { pkd[k][2 * n] = cvt_pk_bf16(a8[k][0], a8[k][1]); pkd[k][2 * n + 1] = cvt_pk_bf16(a8[k][2], a8[k][3]); } }
#pragma unroll
        for (int k = 0; k < 8; ++k) if (!(fr == 0 && k < 2)) *(u32x4*)(ACT + (size_t)(T0 + k) * 5632 + jb) = (u32x4){pkd[k][0], pkd[k][1], pkd[k][2], pkd[k][3]};
    }
};

template <class Epi, class Sched, bool ALIGN_EPI = false, bool SP2 = false>
__device__ __forceinline__ void gemm_phase(PG8_LAS unsigned char* lds, const Gemm g, const Sched& S, const Epi& E, const int wid) {
    const int lane = mk_lane_id(), tid = wid * 64 + lane, wr = wid >> 2, wc = wid & 3, fr = lane & 15, fq = lane >> 4;
    const int K = g.K, nt = K / BK, nt2 = g.K2 ? g.K2 / BK : nt, lda = g.lda, ldb = g.ldb ? g.ldb : K;
#define PG8_KOFS(pn) ((pn) >= g.koff_pn ? (size_t)g.koff * 2 : (size_t)0)
    unsigned voffA[2], voffB[2];
#pragma unroll
    for (int i = 0; i < 2; ++i) { int R, C; stage_rc(tid * 16 + i * 8192, R, C); const int Rb = Epi::PERM ? ((R & ~31) + perm32(R & 31)) : R;
        const int Ra = Epi::ROWPERM ? (8 * (16 * (R >> 6) + (R & 15)) + ((R >> 4) & 3)) : R;
        voffA[i] = (unsigned)(Ra * lda + C) * 2u; voffB[i] = (unsigned)(Rb * ldb + C) * 2u; }
    const size_t kstep = (size_t)(BK * 2);
    const size_t hstepA = Epi::ROWPERM ? (size_t)4 * lda * 2 : (size_t)HALF * lda * 2, hstepB = (size_t)HALF * ldb * 2;
    const size_t tstepA = (size_t)BM * lda * 2, tstepB = 2 * hstepB;
#define PG8_ABASE(pm) ((pm) < g.pm_split ? (const char*)g.A + (size_t)(pm) * tstepA : (const char*)g.A1 + (size_t)((pm) - g.pm_split) * tstepA)
    const unsigned ldsw = (unsigned)wid * 1024u;
    const int aoff = lds_byte(wr * 64 + fr, fq * 8), boff = lds_byte(wc * 32 + fr, fq * 8);
#define PG8_SA(b, h) (((b) * 2 + (h)) * HTB)
#define PG8_SB(b, h) ((4 + (b) * 2 + (h)) * HTB)
#define PG8_STAGE(bufoff, gbase, voff) do { _Pragma("unroll") for (int _i = 0; _i < 2; ++_i) \
        __builtin_amdgcn_global_load_lds((const unsigned*)((const char*)(gbase) + (voff)[_i]), (PG8_LAS unsigned*)(lds + (bufoff) + ldsw + _i * 8192), 16, 0, 0); } while (0)
#define PG8_LDA(dst, b, h) do { _Pragma("unroll") for (int m = 0; m < 4; ++m) _Pragma("unroll") for (int k = 0; k < 2; ++k) dst[m][k] = *(const PG8_LAS bf16x8*)(lds + PG8_SA(b, h) + aoff + m * 2048 + k * 1024); } while (0)
#define PG8_LDB(dst, b, h) do { _Pragma("unroll") for (int n = 0; n < 2; ++n) _Pragma("unroll") for (int k = 0; k < 2; ++k) dst[n][k] = *(const PG8_LAS bf16x8*)(lds + PG8_SB(b, h) + boff + n * 2048 + k * 1024); } while (0)
#define PG8_MMA(ai, bj, At, Bt) do { __builtin_amdgcn_s_setprio(1); _Pragma("unroll") for (int m = 0; m < 4; ++m) _Pragma("unroll") for (int n = 0; n < 2; ++n) _Pragma("unroll") for (int k = 0; k < 2; ++k) \
        acc[ai][bj][m][n] = __builtin_amdgcn_mfma_f32_16x16x32_bf16(Bt[n][k], At[m][k], acc[ai][bj][m][n], 0, 0, 0); __builtin_amdgcn_s_setprio(0); } while (0)
#define PG8_WAIT_V(n) asm volatile("s_waitcnt vmcnt(" #n ")" ::: "memory")
#define PG8_WAIT_L(n) asm volatile("s_waitcnt lgkmcnt(" #n ")" ::: "memory")
#define PG8_BAR __builtin_amdgcn_s_barrier()
#define PG8_SCHED __builtin_amdgcn_sched_barrier(0)
    Unit cur, nxt; int ui = 0;
    if (!S.next(0, cur)) return;
    f32x4 acc[2][2][4][2];
#pragma unroll
    for (int a = 0; a < 2; ++a)
#pragma unroll
        for (int b = 0; b < 2; ++b)
#pragma unroll
            for (int m = 0; m < 4; ++m)
#pragma unroll
                for (int n = 0; n < 2; ++n) acc[a][b][m][n] = (f32x4){0.f, 0.f, 0.f, 0.f};
    bf16x8 At[4][2], B0[2][2], B1[2][2];
    const char* cA = PG8_ABASE(cur.pm) + PG8_KOFS(cur.pn); const char* cB = (const char*)g.Bt + (size_t)cur.pn * tstepB + PG8_KOFS(cur.pn);
    S.a_ready(cur);
    if constexpr (SP2) {
        PG8_STAGE(PG8_SB(0, 0), cB, voffB); PG8_STAGE(PG8_SB(0, 1), cB + hstepB, voffB); PG8_STAGE(PG8_SA(0, 0), cA, voffA); PG8_STAGE(PG8_SA(0, 1), cA + hstepA, voffA);
        if (wr == 1) PG8_BAR;
        PG8_WAIT_V(2); PG8_BAR;
        PG8_STAGE(PG8_SB(1, 0), cB + kstep, voffB); PG8_STAGE(PG8_SA(1, 0), cA + kstep, voffA); PG8_STAGE(PG8_SB(1, 1), cB + hstepB + kstep, voffB);
        PG8_WAIT_V(6); PG8_BAR;
    } else {
        PG8_STAGE(PG8_SB(0, 0), cB, voffB); PG8_STAGE(PG8_SA(0, 0), cA, voffA); PG8_STAGE(PG8_SB(0, 1), cB + hstepB, voffB); PG8_STAGE(PG8_SA(0, 1), cA + hstepA, voffA);
        if (wr == 1) PG8_BAR;
        PG8_WAIT_V(4); PG8_BAR;
        PG8_STAGE(PG8_SB(1, 0), cB + kstep, voffB); PG8_STAGE(PG8_SA(1, 0), cA + kstep, voffA); PG8_STAGE(PG8_SB(1, 1), cB + hstepB + kstep, voffB);
        PG8_WAIT_V(6); PG8_BAR;
    }
    for (;;) {
        const bool has_next = S.next(ui + 1, nxt);
        const char* nA = has_next ? PG8_ABASE(nxt.pm) + PG8_KOFS(nxt.pn) : cA; const char* nB = has_next ? (const char*)g.Bt + (size_t)nxt.pn * tstepB + PG8_KOFS(nxt.pn) : cB;
        const int ntu = (cur.pn >= g.koff_pn) ? nt : nt2;
        for (int t = 0; t < ntu; t += 2) {
            const bool last = (t == ntu - 2);
            const char* a1 = cA + (size_t)(t + 1) * kstep;
            const char* a2 = last ? nA : cA + (size_t)(t + 2) * kstep; const char* b2 = last ? nB : cB + (size_t)(t + 2) * kstep;
            const char* a3 = a2 + kstep; const char* b3 = b2 + kstep;
            if (last && has_next) S.a_ready(nxt);
            if constexpr (SP2) {
            PG8_LDB(B0, 0, 0); PG8_LDB(B1, 0, 1); PG8_SCHED; PG8_LDA(At, 0, 0); PG8_STAGE(PG8_SA(1, 1), a1 + hstepA, voffA);
            PG8_WAIT_V(8); PG8_WAIT_L(0); PG8_BAR; PG8_MMA(0, 0, At, B0); PG8_MMA(0, 1, At, B1); PG8_BAR; PG8_SCHED;
            PG8_LDA(At, 0, 1); PG8_STAGE(PG8_SB(0, 0), b2, voffB); PG8_STAGE(PG8_SB(0, 1), b2 + hstepB, voffB); PG8_STAGE(PG8_SA(0, 0), a2, voffA);
            PG8_WAIT_V(8); PG8_WAIT_L(0); PG8_BAR; PG8_MMA(1, 0, At, B0); PG8_MMA(1, 1, At, B1); PG8_BAR; PG8_SCHED;
            PG8_LDB(B0, 1, 0); PG8_LDB(B1, 1, 1); PG8_SCHED; PG8_LDA(At, 1, 0); PG8_STAGE(PG8_SA(0, 1), a2 + hstepA, voffA);
            PG8_WAIT_V(8); PG8_WAIT_L(0); PG8_BAR; PG8_MMA(0, 0, At, B0); PG8_MMA(0, 1, At, B1); PG8_BAR; PG8_SCHED;
            PG8_LDA(At, 1, 1); PG8_STAGE(PG8_SB(1, 0), b3, voffB); PG8_STAGE(PG8_SB(1, 1), b3 + hstepB, voffB); PG8_STAGE(PG8_SA(1, 0), a3, voffA);
            PG8_WAIT_V(8); PG8_WAIT_L(0); PG8_BAR; PG8_MMA(1, 0, At, B0); PG8_MMA(1, 1, At, B1); PG8_BAR; PG8_SCHED;
            } else {
            PG8_LDB(B0, 0, 0); PG8_SCHED; PG8_LDA(At, 0, 0); PG8_STAGE(PG8_SA(1, 1), a1 + hstepA, voffA);
            PG8_WAIT_L(8); PG8_BAR; PG8_WAIT_L(0); PG8_MMA(0, 0, At, B0); PG8_BAR; PG8_SCHED;
            PG8_LDB(B1, 0, 1); PG8_STAGE(PG8_SB(0, 0), b2, voffB);
            PG8_BAR; PG8_WAIT_L(0); PG8_MMA(0, 1, At, B1); PG8_BAR;
            PG8_LDA(At, 0, 1); PG8_STAGE(PG8_SA(0, 0), a2, voffA);
            PG8_BAR; PG8_WAIT_L(0); PG8_MMA(1, 0, At, B0); PG8_BAR; PG8_SCHED;
            PG8_STAGE(PG8_SB(0, 1), b2 + hstepB, voffB);
            PG8_WAIT_V(6); PG8_BAR; PG8_MMA(1, 1, At, B1); PG8_BAR;
            PG8_LDB(B0, 1, 0); PG8_SCHED; PG8_LDA(At, 1, 0); PG8_STAGE(PG8_SA(0, 1), a2 + hstepA, voffA);
            PG8_WAIT_L(8); PG8_BAR; PG8_WAIT_L(0); PG8_MMA(0, 0, At, B0); PG8_BAR; PG8_SCHED;
            PG8_LDB(B1, 1, 1); PG8_STAGE(PG8_SB(1, 0), b3, voffB);
            PG8_BAR; PG8_WAIT_L(0); PG8_MMA(0, 1, At, B1); PG8_BAR;
            PG8_LDA(At, 1, 1); PG8_STAGE(PG8_SA(1, 0), a3, voffA);
            PG8_BAR; PG8_WAIT_L(0); PG8_MMA(1, 0, At, B0); PG8_BAR; PG8_SCHED;
            PG8_STAGE(PG8_SB(1, 1), b3 + hstepB, voffB);
            PG8_WAIT_V(6); PG8_BAR; PG8_MMA(1, 1, At, B1); PG8_BAR;
            }
        }
        if constexpr (ALIGN_EPI) { if (wr == 0) PG8_BAR; }
        if constexpr (!Epi::AFTER_DRAIN) { E(acc, cur, wr, wc, fr, fq); S.done(cur); }
        if (!has_next) break;
#pragma unroll
        for (int a = 0; a < 2; ++a)
#pragma unroll
            for (int b = 0; b < 2; ++b)
#pragma unroll
                for (int m = 0; m < 4; ++m)
#pragma unroll
                    for (int n = 0; n < 2; ++n) acc[a][b][m][n] = (f32x4){0.f, 0.f, 0.f, 0.f};
        cur = nxt; cA = nA; cB = nB; ++ui;
        if constexpr (ALIGN_EPI) { if (wr == 1) PG8_BAR; }
    }
    PG8_WAIT_V(0);
    if constexpr (!ALIGN_EPI) { if (wr == 0) PG8_BAR; }
    PG8_BAR;
    if constexpr (Epi::AFTER_DRAIN) { E.fused(acc, cur, wr, wc, fr, fq, lds, wid, lane); S.done(cur); }
#undef PG8_ABASE
#undef PG8_KOFS
#undef PG8_SA
#undef PG8_SB
#undef PG8_STAGE
#undef PG8_LDA
#undef PG8_LDB
#undef PG8_MMA
#undef PG8_WAIT_V
#undef PG8_WAIT_L
#undef PG8_BAR
#undef PG8_SCHED
}
}

#include <hip/hip_bf16.h>
#include <cmath>
namespace attn_body {
using bf16=__hip_bfloat16;
using bf16x8=__attribute__((ext_vector_type(8)))short;
using s16x4=__attribute__((ext_vector_type(4)))short;
using f32x16=__attribute__((ext_vector_type(16)))float;
using u32x4=__attribute__((ext_vector_type(4)))unsigned;
constexpr int BATCH=4,SEQ=4096,D=64,DM=6912,OPITCH=2048;
constexpr int NW=8,QBLK=32,QB=QBLK*NW,KVBLK=64,NQB=SEQ/QB;
constexpr int ATTN_PITCH=DM, ATTN_UNIT_ROWS=QB;
__device__ __forceinline__ int crow(int r,int hi){return (r&3)+8*(r>>2)+4*hi;}
#define SBAR() __builtin_amdgcn_sched_barrier(0)
typedef __attribute__((address_space(3))) const float* lds_cfptr;
__device__ __forceinline__ void bias_add(f32x16&p0,f32x16&p1,lds_cfptr tabr,int cb){
  #pragma unroll
  for(int r=0;r<16;++r){const int k=(r&3)+8*(r>>2); p0[r]+=tabr[cb+k]; p1[r]+=tabr[cb+k+32];}
}
constexpr int LDS_TAB=110592, TAB_N=640;
constexpr int NSLOT=3, SLOTB=8192;
constexpr int LDS_K=0, LDS_V=NSLOT*SLOTB, LDS_WS=3*NSLOT*SLOTB, LDS_OST=LDS_WS+NW*64*4, LDS_BYTES=LDS_OST+NW*4096;
constexpr float C2=0.125f*1.4426950408889634f;
__device__ __forceinline__ void glds16(const void*gsrc,unsigned lds_dst){unsigned keep;
  asm volatile("s_mov_b32 %0, m0\n\ts_mov_b32 m0, %2\n\ts_nop 0\n\tglobal_load_lds_dwordx4 %1, off\n\ts_mov_b32 m0, %0":"=&s"(keep):"v"(gsrc),"s"(lds_dst):"memory");}
__device__ __forceinline__ float max3f(float a,float b,float c){float r;asm("v_max3_f32 %0, %1, %2, %3":"=v"(r):"v"(a),"v"(b),"v"(c));return r;}
__device__ __forceinline__ float max2f(float a,float b){float r;asm("v_max_f32_e32 %0, %1, %2":"=v"(r):"v"(a),"v"(b));return r;}
__device__ __forceinline__ float fadd_s(float a,float b){float r;asm("v_add_f32_e32 %0, %1, %2":"=v"(r):"v"(a),"v"(b));return r;}
__device__ __forceinline__ float fsub_s(float a,float b){float r;asm("v_sub_f32_e32 %0, %1, %2":"=v"(r):"v"(a),"v"(b));return r;}
typedef float f32x2_t __attribute__((ext_vector_type(2))); typedef __bf16 bf16x2_t __attribute__((ext_vector_type(2)));
__device__ __forceinline__ unsigned cvtpk_s(float lo,float hi){f32x2_t v={lo,hi};bf16x2_t b=__builtin_convertvector(v,bf16x2_t);return __builtin_bit_cast(unsigned,b);}
#define WAIT_BAR(N) asm volatile("s_waitcnt vmcnt(" #N ") lgkmcnt(0)\n\ts_barrier":::"memory")

__device__ __forceinline__ void qkt(f32x16&p0,f32x16&p1,const char*Kslot,const bf16x8*qr,const f32x16&negm,int r32,int hi){
  const char*kb=Kslot+hi*1024+r32*16;
  #pragma unroll
  for(int d0=0;d0<4;++d0){
    const bf16x8 b0=*reinterpret_cast<const bf16x8*>(kb+d0*2048);
    const bf16x8 b1=*reinterpret_cast<const bf16x8*>(kb+d0*2048+512);
    if(d0==0){p0=__builtin_amdgcn_mfma_f32_32x32x16_bf16(b0,qr[0],negm,0,0,0);p1=__builtin_amdgcn_mfma_f32_32x32x16_bf16(b1,qr[0],negm,0,0,0);}
    else{p0=__builtin_amdgcn_mfma_f32_32x32x16_bf16(b0,qr[d0],p0,0,0,0);p1=__builtin_amdgcn_mfma_f32_32x32x16_bf16(b1,qr[d0],p1,0,0,0);}}
}
typedef __attribute__((address_space(3))) const char* lds_cptr;
typedef short v4i16_t __attribute__((ext_vector_type(4)));
__device__ __forceinline__ void kload8(bf16x8*kf,lds_cptr kp){
  kf[0]=*(const __attribute__((address_space(3))) bf16x8*)(kp);      kf[1]=*(const __attribute__((address_space(3))) bf16x8*)(kp+512);
  kf[2]=*(const __attribute__((address_space(3))) bf16x8*)(kp+2048); kf[3]=*(const __attribute__((address_space(3))) bf16x8*)(kp+2560);
  kf[4]=*(const __attribute__((address_space(3))) bf16x8*)(kp+4096); kf[5]=*(const __attribute__((address_space(3))) bf16x8*)(kp+4608);
  kf[6]=*(const __attribute__((address_space(3))) bf16x8*)(kp+6144); kf[7]=*(const __attribute__((address_space(3))) bf16x8*)(kp+6656);
}
__device__ __forceinline__ void kload2(bf16x8*kf,lds_cptr kp,int j){ kf[2*j]=*(const __attribute__((address_space(3))) bf16x8*)(kp+j*2048); kf[2*j+1]=*(const __attribute__((address_space(3))) bf16x8*)(kp+j*2048+512); }
__device__ __forceinline__ s16x4 vtr(lds_cptr p){ return __builtin_bit_cast(s16x4,__builtin_amdgcn_ds_read_tr16_b64_v4i16((__attribute__((address_space(3))) v4i16_t*)p)); }
__device__ __forceinline__ float rowmax(const f32x16&p0,const f32x16&p1){
  float a=max3f(p0[0],p0[1],p1[0]),b=max3f(p0[2],p0[3],p1[1]);a=max3f(a,p1[2],p1[3]);
  #pragma unroll
  for(int r=4;r<16;r+=4){a=max3f(a,p0[r],p0[r+1]);b=max3f(b,p0[r+2],p0[r+3]);a=max3f(a,p1[r],p1[r+1]);b=max3f(b,p1[r+2],p1[r+3]);}
  const float m=max2f(a,b);
  auto rr=__builtin_amdgcn_permlane32_swap(__float_as_uint(m),__float_as_uint(m),false,false);
  return max2f(__uint_as_float(rr[0]),__uint_as_float(rr[1]));
}
__device__ __forceinline__ void pv(f32x16*o,int vb,bf16x8 pa0,bf16x8 pa1,bf16x8 pa2,bf16x8 pa3){
  #pragma unroll
  for(int d0=0;d0<2;++d0){s16x4 lo[4],hi[4];
    #pragma unroll
    for(int ks=0;ks<4;++ks){
      asm volatile("ds_read_b64_tr_b16 %0,%1 offset:%c2":"=&v"(lo[ks]):"v"(vb),"i"(d0*4096+ks*1024):"memory");
      asm volatile("ds_read_b64_tr_b16 %0,%1 offset:%c2":"=&v"(hi[ks]):"v"(vb),"i"(d0*4096+ks*1024+512):"memory");}
    asm volatile("s_waitcnt lgkmcnt(0)":::"memory");SBAR();
    #define PK(k) (bf16x8){lo[k][0],lo[k][1],lo[k][2],lo[k][3],hi[k][0],hi[k][1],hi[k][2],hi[k][3]}
    o[d0]=__builtin_amdgcn_mfma_f32_32x32x16_bf16(pa0,PK(0),o[d0],0,0,0);
    o[d0]=__builtin_amdgcn_mfma_f32_32x32x16_bf16(pa1,PK(1),o[d0],0,0,0);
    o[d0]=__builtin_amdgcn_mfma_f32_32x32x16_bf16(pa2,PK(2),o[d0],0,0,0);
    o[d0]=__builtin_amdgcn_mfma_f32_32x32x16_bf16(pa3,PK(3),o[d0],0,0,0);
    #undef PK
  }
}

#ifndef ATTN_STORE16
#define ATTN_STORE16(p,v) (*(u32x4*)(p)=(v))
#endif
template<int THRL> __device__ __forceinline__ void attn_unit(int b,int qcol,int kcol,int vcol,int ocol,int qb,const bf16*__restrict__ PB,bf16*O,char*shm,const int wid,const int tab_off,unsigned*qctr,volatile __attribute__((address_space(3))) unsigned*slot,
                                                             const bool second,bf16*PQ,const int pqcol,const float*lamp,const float*subg){
  const int lane=mk_lane_id(),r32=lane&31,hi=lane>>5;
  const long rowbase=(long)b*SEQ; const int q0=qb*QB;
  const bf16*Qw=PB+(rowbase+q0+wid*QBLK)*DM+qcol;
  const bf16*Kh=PB+rowbase*DM+kcol,*Vh=PB+rowbase*DM+vcol;
  const unsigned lds0=(unsigned)(uintptr_t)shm;
  __attribute__((address_space(3))) float*wsf=(__attribute__((address_space(3))) float*)(shm+LDS_WS)+wid*64;
  const bf16*ksrc=Kh+(long)lane*DM+wid*8;
  const bf16*vsrc=Vh+(long)(16*(wid&3)+(lane>>2))*DM+(wid>>2)*32+(lane&3)*8;
  const unsigned kdst=lds0+LDS_K+wid*1024, vdst=lds0+LDS_V+wid*1024;
  #define DMA_K(t,slot) glds16(ksrc+(long)(t)*KVBLK*DM,(unsigned)__builtin_amdgcn_readfirstlane(kdst+(slot)))
  #define DMA_V(t,slot) do{ glds16(vsrc+(long)(t)*KVBLK*DM,(unsigned)__builtin_amdgcn_readfirstlane(vdst+2*(slot))); glds16(vsrc+64+(long)(t)*KVBLK*DM,(unsigned)__builtin_amdgcn_readfirstlane(vdst+2*(slot)+8192)); }while(0)
  const char*Kbase=shm+LDS_K; bf16x8 kf[8];
  const lds_cptr shm3=(lds_cptr)shm; const lds_cptr kp0=shm3+LDS_K+hi*1024+r32*16; const lds_cptr vp0=shm3+LDS_V+((lane>>4)&1)*32+(lane&3)*8+(4*hi+((lane&15)>>2))*64;
  const int NT=(q0+QB)/KVBLK;
  DMA_K(0,0);DMA_V(0,0);DMA_K(1,SLOTB);
  bf16x8 qr[4];
  #pragma unroll
  for(int d0=0;d0<4;++d0)qr[d0]=*reinterpret_cast<const bf16x8*>(&Qw[(long)r32*DM+d0*16+hi*8]);
  float mhat=0.f,l_reg=0.f;f32x16 o[4];o[0]=f32x16{};o[1]=f32x16{};o[2]=f32x16{};o[3]=f32x16{};f32x16 negm=f32x16{};asm volatile("":"+v"(negm));
  const int qrel=wid*QBLK+r32; const lds_cfptr tabr=(lds_cfptr)(shm3+LDS_TAB); const int cb0=tab_off+383-q0-qrel+4*hi;
  #define CMASK(P0,P1,t) do{ if((t)>=NT-6) bias_add(P0,P1,tabr,cb0+64*(t)); }while(0)
  bool resc=false;
  #define START(P0,P1) do{ const float rm=rowmax(P0,P1); resc=false; \
    { const float dl=rm; mhat=fadd_s(mhat,dl); \
      _Pragma("unroll") for(int r=0;r<16;++r){P0[r]=fsub_s(P0[r],dl);P1[r]=fsub_s(P1[r],dl);} \
      _Pragma("unroll") for(int r=0;r<16;++r)negm[r]=-mhat; asm volatile("":"+v"(negm)); } \
    _Pragma("unroll") for(int r=0;r<16;++r)P0[r]=__builtin_amdgcn_exp2f(P0[r]); }while(0)
  #define RESC() do{ if(resc){ asm volatile("s_waitcnt lgkmcnt(0)":::"memory"); \
      _Pragma("unroll") for(int d_=0;d_<4;++d_) _Pragma("unroll") for(int r=0;r<16;++r)o[d_][r]*=wsf[crow(r,hi)]; } }while(0)
  f32x16 pA0,pA1,pB0,pB1;
  int sl_prev=0,sl_cur=0,sl_next=SLOTB;
  #define ROT() do{sl_prev=sl_cur;sl_cur=sl_next;sl_next=(sl_next==(NSLOT-1)*SLOTB)?0:sl_next+SLOTB;}while(0)
  DMA_K(2,2*SLOTB);
  WAIT_BAR(4);
  qkt(pA0,pA1,Kbase,qr,negm,r32,hi);asm volatile("s_nop 15\n\ts_nop 7":"+v"(pA0),"+v"(pA1));CMASK(pA0,pA1,0);
  START(pA0,pA1);
  _Pragma("unroll") for(int r=0;r<16;++r)pA1[r]=__builtin_amdgcn_exp2f(pA1[r]);
  WAIT_BAR(0);
  DMA_K(3,0);DMA_V(1,SLOTB);
  ROT();
  kload8(kf,kp0+sl_cur);
  WAIT_BAR(3);
  s16x4 vlo[8],vhi[8]; u32x4 pw0,pw1,pw2,pw3;
  #define PKW(P,B) cvtpk_s(P[B],P[B+1])
  #define PAF(k) __builtin_bit_cast(bf16x8,pw##k)
  #define VFR(i) (bf16x8){vlo[i][0],vlo[i][1],vlo[i][2],vlo[i][3],vhi[i][0],vhi[i][1],vhi[i][2],vhi[i][3]}
  #define PIN(x) asm volatile("":"+v"(x))
  #define MX3(a,b,c) __builtin_fmaxf(__builtin_fmaxf((a),(b)),(c))
  #define GAPA(MF,A0,A1,A2,A3,W0,W1,PW) do{ MF; sacc+=A0; sacc+=A1; sacc+=A2; sacc+=A3; PIN(sacc); W0; W1; PIN(PW); SBAR(); }while(0)
  #define EX(v) __builtin_amdgcn_exp2f(v)
  #define GAPB(MF,X,B) do{ MF; X[B]=EX(X[B]); X[B+1]=EX(X[B+1]); PIN(X); SBAR(); }while(0)
  #define VRD(i) do{ vlo[i]=vtr(vp_+(((i)>>2)*4096+((i)&3)*1024)); vhi[i]=vtr(vp_+(((i)>>2)*4096+((i)&3)*1024+512)); }while(0)
  #define VRD2(i) do{ vlo[i]=vtr(vp_+(8192+((i)>>2)*4096+((i)&3)*1024)); vhi[i]=vtr(vp_+(8192+((i)>>2)*4096+((i)&3)*1024+512)); }while(0)
  #define KRD(G,j) do{ if(G){ kload2(kf,kp0+sl_next,j); SBAR(); } }while(0)
  #define STEP(C0,C1,P0,P1,t,GK,GV,GL) do{ SBAR(); \
    const lds_cptr vp_=vp0+2*sl_prev; \
    VRD(0); SBAR(); float sacc=(P0[0]+P0[1]); \
    GAPA(C0=__builtin_amdgcn_mfma_f32_32x32x16_bf16(kf[0],qr[0],negm,0,0,0), P0[2],P0[3],P0[4],P0[5],     pw0[0]=PKW(P0,0), pw0[1]=PKW(P0,2), pw0); \
    VRD(4); SBAR(); GAPA(C1=__builtin_amdgcn_mfma_f32_32x32x16_bf16(kf[1],qr[0],negm,0,0,0), P0[6],P0[7],P0[8],P0[9],     pw0[2]=PKW(P0,4), pw0[3]=PKW(P0,6), pw0); \
    VRD(1); SBAR(); GAPA(C0=__builtin_amdgcn_mfma_f32_32x32x16_bf16(kf[2],qr[1],C0,0,0,0),   P0[10],P0[11],P0[12],P0[13], pw1[0]=PKW(P0,8), pw1[1]=PKW(P0,10), pw1); \
    VRD(5); SBAR(); GAPA(C1=__builtin_amdgcn_mfma_f32_32x32x16_bf16(kf[3],qr[1],C1,0,0,0),   P0[14],P0[15],P1[0],P1[1],   pw1[2]=PKW(P0,12),pw1[3]=PKW(P0,14), pw1); \
    GAPA(C0=__builtin_amdgcn_mfma_f32_32x32x16_bf16(kf[4],qr[2],C0,0,0,0),   P1[2],P1[3],P1[4],P1[5],     pw2[0]=PKW(P1,0), pw2[1]=PKW(P1,2), pw2); \
    GAPA(C1=__builtin_amdgcn_mfma_f32_32x32x16_bf16(kf[5],qr[2],C1,0,0,0),   P1[6],P1[7],P1[8],P1[9],     pw2[2]=PKW(P1,4), pw2[3]=PKW(P1,6), pw2); \
    GAPA(C0=__builtin_amdgcn_mfma_f32_32x32x16_bf16(kf[6],qr[3],C0,0,0,0),   P1[10],P1[11],P1[12],P1[13], pw3[0]=PKW(P1,8), pw3[1]=PKW(P1,10), pw3); \
    GAPA(C1=__builtin_amdgcn_mfma_f32_32x32x16_bf16(kf[7],qr[3],C1,0,0,0),   P1[14],P1[15],0.f,0.f,       pw3[2]=PKW(P1,12),pw3[3]=PKW(P1,14), pw3); \
    l_reg+=sacc; \
    if(GK){DMA_K((t)+3,sl_cur);} if(GV){DMA_V((t)+1,sl_next);} \
    CMASK(C0,C1,t); \
    { float a=MX3(C0[0],C0[1],C1[0]),b=MX3(C0[2],C0[3],C1[1]); a=MX3(a,C1[2],C1[3]); \
      _Pragma("unroll") for(int r=4;r<16;r+=4){a=MX3(a,C0[r],C0[r+1]);b=MX3(b,C0[r+2],C0[r+3]);a=MX3(a,C1[r],C1[r+1]);b=MX3(b,C1[r+2],C1[r+3]);} \
      float rm=__builtin_fmaxf(a,b); { auto rr=__builtin_amdgcn_permlane32_swap(__float_as_uint(rm),__float_as_uint(rm),false,false); rm=__builtin_fmaxf(__uint_as_float(rr[0]),__uint_as_float(rr[1])); } \
      resc=false; \
      if(__builtin_expect(__any(rm>(float)THRL),0)){ const float dl=__builtin_fmaxf(rm,0.f); mhat+=dl; \
        _Pragma("unroll") for(int r=0;r<16;++r){C0[r]-=dl;C1[r]-=dl;} \
        _Pragma("unroll") for(int r=0;r<16;++r)negm[r]=-mhat; asm volatile("":"+v"(negm)); \
        const float f=__builtin_amdgcn_exp2f(-dl); l_reg*=f; if(hi==0)wsf[r32]=f; resc=true; } } \
    SBAR(); \
    VRD(2); SBAR(); GAPB(o[0]=__builtin_amdgcn_mfma_f32_32x32x16_bf16(PAF(0),VFR(0),o[0],0,0,0), C0,0); \
    VRD(6); SBAR(); GAPB(o[1]=__builtin_amdgcn_mfma_f32_32x32x16_bf16(PAF(0),VFR(4),o[1],0,0,0), C0,2); \
    VRD(3); SBAR(); KRD(GL,0); GAPB(o[0]=__builtin_amdgcn_mfma_f32_32x32x16_bf16(PAF(1),VFR(1),o[0],0,0,0), C0,4); \
    VRD(7); SBAR(); KRD(GL,1); GAPB(o[1]=__builtin_amdgcn_mfma_f32_32x32x16_bf16(PAF(1),VFR(5),o[1],0,0,0), C0,6); \
    VRD2(0); SBAR(); KRD(GL,2); GAPB(o[0]=__builtin_amdgcn_mfma_f32_32x32x16_bf16(PAF(2),VFR(2),o[0],0,0,0), C0,8); \
    VRD2(4); SBAR(); KRD(GL,3); GAPB(o[1]=__builtin_amdgcn_mfma_f32_32x32x16_bf16(PAF(2),VFR(6),o[1],0,0,0), C0,10); \
    VRD2(1); SBAR(); GAPB(o[0]=__builtin_amdgcn_mfma_f32_32x32x16_bf16(PAF(3),VFR(3),o[0],0,0,0), C0,12); \
    VRD2(5); SBAR(); GAPB(o[1]=__builtin_amdgcn_mfma_f32_32x32x16_bf16(PAF(3),VFR(7),o[1],0,0,0), C0,14); \
      \
    VRD2(2); SBAR(); GAPB(o[2]=__builtin_amdgcn_mfma_f32_32x32x16_bf16(PAF(0),VFR(0),o[2],0,0,0), C1,0); \
    VRD2(6); SBAR(); GAPB(o[3]=__builtin_amdgcn_mfma_f32_32x32x16_bf16(PAF(0),VFR(4),o[3],0,0,0), C1,2); \
    VRD2(3); SBAR(); GAPB(o[2]=__builtin_amdgcn_mfma_f32_32x32x16_bf16(PAF(1),VFR(1),o[2],0,0,0), C1,4); \
    VRD2(7); SBAR(); GAPB(o[3]=__builtin_amdgcn_mfma_f32_32x32x16_bf16(PAF(1),VFR(5),o[3],0,0,0), C1,6); \
    GAPB(o[2]=__builtin_amdgcn_mfma_f32_32x32x16_bf16(PAF(2),VFR(2),o[2],0,0,0), C1,8); \
    GAPB(o[3]=__builtin_amdgcn_mfma_f32_32x32x16_bf16(PAF(2),VFR(6),o[3],0,0,0), C1,10); \
    GAPB(o[2]=__builtin_amdgcn_mfma_f32_32x32x16_bf16(PAF(3),VFR(3),o[2],0,0,0), C1,12); \
    GAPB(o[3]=__builtin_amdgcn_mfma_f32_32x32x16_bf16(PAF(3),VFR(7),o[3],0,0,0), C1,14); \
    }while(0)
  int t=1;
  #undef CMASK
  #define CMASK(P0,P1,t) do{}while(0)
  for(;t+7<NT;t+=2){
    STEP(pB0,pB1,pA0,pA1,t,true,true,true);     WAIT_BAR(3); RESC(); ROT();
    STEP(pA0,pA1,pB0,pB1,t+1,true,true,true);   WAIT_BAR(3); RESC(); ROT();
  }
  #undef CMASK
  #define CMASK(P0,P1,t) do{ if((t)>=NT-6) bias_add(P0,P1,tabr,cb0+64*(t)); }while(0)
  #define ENDW(tt) do{ if((tt)+3<NT){WAIT_BAR(3);} else if((tt)+2<NT){WAIT_BAR(2);} else {WAIT_BAR(0);} }while(0)
  for(;t+1<NT;t+=2){
    STEP(pB0,pB1,pA0,pA1,t,(t+3<NT),(t+1<NT),(t+1<NT));       ENDW(t);   RESC(); ROT();
    STEP(pA0,pA1,pB0,pB1,t+1,(t+4<NT),(t+2<NT),(t+2<NT));     ENDW(t+1); RESC(); ROT();
  }
  STEP(pB0,pB1,pA0,pA1,NT-1,false,false,false); RESC();
  { float sacc=pB0[0]+pB0[1]; _Pragma("unroll") for(int r=2;r<16;++r)sacc+=pB0[r]; _Pragma("unroll") for(int r=0;r<16;++r)sacc+=pB1[r]; l_reg+=sacc;
    pw0=(u32x4){PKW(pB0,0),PKW(pB0,2),PKW(pB0,4),PKW(pB0,6)};pw1=(u32x4){PKW(pB0,8),PKW(pB0,10),PKW(pB0,12),PKW(pB0,14)};pw2=(u32x4){PKW(pB1,0),PKW(pB1,2),PKW(pB1,4),PKW(pB1,6)};pw3=(u32x4){PKW(pB1,8),PKW(pB1,10),PKW(pB1,12),PKW(pB1,14)};
    SBAR(); pv(o,(int)(uintptr_t)vp0+2*sl_cur,PAF(0),PAF(1),PAF(2),PAF(3)); pv(o+2,(int)(uintptr_t)vp0+2*sl_cur+8192,PAF(0),PAF(1),PAF(2),PAF(3)); }
  #undef PKW
  #undef PAF
  #undef VFR
  #undef PIN
  #undef MX3
  #undef GAPA
  #undef GAPB
  #undef EX
  #undef VRD
  #undef VRD2
  #undef KRD
  #undef STEP
  #undef ENDW
  {auto rr=__builtin_amdgcn_permlane32_swap(__float_as_uint(l_reg),__float_as_uint(l_reg),false,false);l_reg=__uint_as_float(rr[0])+__uint_as_float(rr[1]);}
  if(hi==0)wsf[32+r32]=l_reg;asm volatile("s_waitcnt lgkmcnt(0)":::"memory");
  float rli[16];
  #pragma unroll
  for(int r=0;r<16;++r)rli[r]=__builtin_amdgcn_rcpf(wsf[32+crow(r,hi)]);
  bf16*Ow=O+(rowbase+q0+wid*QBLK)*OPITCH+ocol;
  unsigned nxt=0u; const bool ldr=(wid==0&&lane==0); if(second&&ldr)nxt=__hip_atomic_fetch_add(qctr,1u,__ATOMIC_RELAXED,__HIP_MEMORY_SCOPE_AGENT);
  bf16*stg=(bf16*)(shm+LDS_OST)+wid*2048;
  if(!second){
    #pragma unroll
    for(int hp=0;hp<2;++hp){
      #pragma unroll
      for(int r=0;r<16;++r){const int orow=crow(r,hi);
        #pragma unroll
        for(int d0=0;d0<2;++d0)stg[orow*64+d0*32+r32]=__float2bfloat16(o[2*hp+d0][r]*rli[r]);}
      asm volatile("s_waitcnt lgkmcnt(0)":::"memory");
      #pragma unroll
      for(int i=0;i<4;++i){const int row=i*8+(lane>>3),ch=lane&7; const u32x4 v=*(const u32x4*)(stg+row*64+ch*8); ATTN_STORE16(Ow+(long)row*OPITCH+hp*64+ch*8,v);}
      asm volatile("s_waitcnt lgkmcnt(0)":::"memory"); }
  } else {
    const int ch=lane&7, rw=lane>>3; u32x4 z0[2][4]; const float lam=*lamp;
    #pragma unroll
    for(int hp=0;hp<2;++hp)
      #pragma unroll
      for(int i=0;i<4;++i)z0[hp][i]=*(const u32x4*)(Ow+(long)(i*8+rw)*OPITCH+hp*64+ch*8);
    float dd[2][4][8],ssr[4]={0.f,0.f,0.f,0.f};
    #pragma unroll
    for(int hp=0;hp<2;++hp){
      #pragma unroll
      for(int r=0;r<16;++r){const int orow=crow(r,hi);
        #pragma unroll
        for(int d0=0;d0<2;++d0)stg[orow*64+d0*32+r32]=__float2bfloat16(o[2*hp+d0][r]*rli[r]);}
      asm volatile("s_waitcnt lgkmcnt(0)":::"memory");
      #pragma unroll
      for(int i=0;i<4;++i){const u32x4 v=*(const u32x4*)(stg+(i*8+rw)*64+ch*8); const u32x4 w=z0[hp][i];
        #pragma unroll
        for(int e=0;e<4;++e){ const float x1l=__uint_as_float(v[e]<<16),x1h=__uint_as_float(v[e]&0xFFFF0000u),x0l=__uint_as_float(w[e]<<16),x0h=__uint_as_float(w[e]&0xFFFF0000u);
          const float dl=x0l-lam*x1l,dh=x0h-lam*x1h; dd[hp][i][2*e]=dl; dd[hp][i][2*e+1]=dh; ssr[i]+=dl*dl; ssr[i]+=dh*dh; } }
      asm volatile("s_waitcnt lgkmcnt(0)":::"memory"); }
    float gsub[2][8];
    #pragma unroll
    for(int hp=0;hp<2;++hp)
      #pragma unroll
      for(int e=0;e<8;++e)gsub[hp][e]=subg[hp*64+ch*8+e]*0.8f;
    bf16*Pw=PQ+(rowbase+q0+wid*QBLK)*(long)DM+pqcol;
    #pragma unroll
    for(int i=0;i<4;++i){ float ss=ssr[i]; ss+=__shfl_xor(ss,1); ss+=__shfl_xor(ss,2); ss+=__shfl_xor(ss,4);
      const float rstd=1.0f/sqrtf(ss*(1.0f/128.0f)+1e-6f);
      #pragma unroll
      for(int hp=0;hp<2;++hp){ u32x4 ov;
        #pragma unroll
        for(int e=0;e<4;++e)ov[e]=cvtpk_s(dd[hp][i][2*e]*rstd*gsub[hp][2*e],dd[hp][i][2*e+1]*rstd*gsub[hp][2*e+1]);
        ATTN_STORE16(Pw+(long)(i*8+rw)*DM+hp*64+ch*8,ov); } }
  }
  if(second&&ldr)slot[0]=nxt;
  asm volatile("s_waitcnt lgkmcnt(0)\n\ts_barrier":::"memory");
  #undef DMA_K
  #undef DMA_V
  #undef CMASK
  #undef START
  #undef RESC
  #undef ROT
}
constexpr int ATTN_LDS_BYTES=LDS_BYTES;
struct AttnArgs { const bf16* P; bf16* O; const float* tab; unsigned* qctr; };
#undef SBAR
#undef WAIT_BAR
}

#define GAS __attribute__((address_space(1)))
#define LAS __attribute__((address_space(3)))
typedef unsigned short bf16;
typedef unsigned v4u __attribute__((ext_vector_type(4)));
typedef float f32x4 __attribute__((ext_vector_type(4)));
typedef short bf16x8 __attribute__((ext_vector_type(8)));
typedef GAS unsigned gu32;
typedef GAS unsigned long long gu64;
#define RLX_AGENT __ATOMIC_RELAXED, __HIP_MEMORY_SCOPE_AGENT
#define LDS_WAIT() asm volatile("s_waitcnt lgkmcnt(0)" ::: "memory")
#define VM_WAIT() asm volatile("s_waitcnt vmcnt(0)" ::: "memory")
__device__ __forceinline__ unsigned long long rt() { return __builtin_amdgcn_s_memrealtime(); }
__device__ __forceinline__ unsigned f2bf(float f) { unsigned u = __builtin_bit_cast(unsigned, f); return (u + 0x7fffu + ((u >> 16) & 1u)) >> 16; }
__device__ __forceinline__ unsigned pk2(float lo, float hi) { return f2bf(lo) | (f2bf(hi) << 16); }

#define XB_TMO      128
#define XB_XCNT(j)  (256  + 64 * (j))
#define XB_XSUB(j)  (1280 + 64 * (j))
#define XB_XGEN(j)  (2304 + 64 * (j))
#define XB_TOP      3328
#define XB_TOPGEN   3392
#define XCD_BAR_WORDS 3456
#define XB_SPIN_CAP (1u << 18)

__device__ __forceinline__ unsigned xb_ld(unsigned* p)              { return __hip_atomic_load(p, __ATOMIC_RELAXED, __HIP_MEMORY_SCOPE_AGENT); }
__device__ __forceinline__ unsigned xb_add(unsigned* p, unsigned v) { return __hip_atomic_fetch_add(p, v, __ATOMIC_RELAXED, __HIP_MEMORY_SCOPE_AGENT); }
__device__ __forceinline__ unsigned xb_xcc_id() { return (unsigned)__builtin_amdgcn_s_getreg((3 << 11) | 20) & 0xFu; }
#define XB_SPIN(cond, bar) do { unsigned _sp = 0; while (cond) { __builtin_amdgcn_s_sleep(1); \
    if ((++_sp & 255u) == 0u) { if (xb_ld(&(bar)[XB_TMO])) break; if (_sp > XB_SPIN_CAP) { atomicAdd(&(bar)[XB_TMO], 1u); break; } } } } while (0)

struct XcdBarrier {
    unsigned* bar; unsigned x;
    volatile LAS unsigned* st;
};

__device__ __forceinline__ XcdBarrier xcd_barrier_post(unsigned* bar, volatile LAS unsigned* st, const bool leader) {
    XcdBarrier b; b.bar = bar; b.x = xb_xcc_id(); b.st = st;
    if (leader) (void)xb_add(&bar[XB_XCNT(b.x)], 1u);
    return b;
}
__device__ __forceinline__ void xcd_barrier_complete(unsigned* bar, unsigned x, unsigned& nloc, unsigned& nx) {
    const unsigned G = gridDim.x * gridDim.y * gridDim.z;
    unsigned sum, cnt, mine, sp = 0u;
    for (;;) {
        sum = 0u; cnt = 0u; mine = 0u;
#pragma unroll
        for (unsigned j = 0; j < 16; ++j) { const unsigned c = xb_ld(&bar[XB_XCNT(j)]); sum += c; cnt += (c > 0u) ? 1u : 0u; mine = (j == x) ? c : mine; }
        if (sum == G) break;
        __builtin_amdgcn_s_sleep(1);
        if ((++sp & 255u) == 0u) { if (xb_ld(&bar[XB_TMO])) break; if (sp > XB_SPIN_CAP) { atomicAdd(&bar[XB_TMO], 1u); break; } }
    }
    nloc = mine > 0u ? mine : 1u; nx = cnt > 0u ? cnt : 1u;
}

__device__ __forceinline__ void xcd_barrier(const XcdBarrier& b, const bool leader) {
    asm volatile("s_waitcnt vmcnt(0)" ::: "memory");
    __syncthreads();
    if (leader) {
        unsigned* bar = b.bar;
        __builtin_amdgcn_s_waitcnt(0);
        unsigned nloc = b.st[0], nx = b.st[1];
        if (nloc == 0u) { xcd_barrier_complete(bar, b.x, nloc, nx); b.st[0] = nloc; b.st[1] = nx; }
        const unsigned old = xb_add(&bar[XB_XSUB(b.x)], 1u);
        const unsigned gen = old / nloc;
        if (old + 1u == (gen + 1u) * nloc) {
            __builtin_amdgcn_fence(__ATOMIC_RELEASE, "agent");
            asm volatile("s_waitcnt vmcnt(0)" ::: "memory");
            const unsigned og = xb_add(&bar[XB_TOP], 1u);
            const unsigned tg = og / nx;
            if (og + 1u == (tg + 1u) * nx) xb_add(&bar[XB_TOPGEN], 1u);
            else XB_SPIN(xb_ld(&bar[XB_TOPGEN]) == tg, bar);
            __builtin_amdgcn_fence(__ATOMIC_ACQUIRE, "agent");
            xb_add(&bar[XB_XGEN(b.x)], 1u);
            asm volatile("s_waitcnt vmcnt(0)" ::: "memory");
        } else {
            XB_SPIN(xb_ld(&bar[XB_XGEN(b.x)]) == gen, bar);
            __builtin_amdgcn_fence(__ATOMIC_ACQUIRE, "agent");
            asm volatile("s_waitcnt vmcnt(0)" ::: "memory");
        }
    }
    __syncthreads();
}

constexpr int NWAVES = 8;
constexpr int BATCH = 4, SEQ = 4096, DMODEL = 2048, M = BATCH * SEQ;
constexpr int NP = 6912;
constexpr int PC_K = 0, PC_V = 1024, PC_Q = 2048, PC_R = 3072, PC_KR = 4096, PC_VR = 5120;
constexpr int PC_W1A = 6144, PC_W1B = 6208, PC_A1A = 6272, PC_A1B = 6336, PC_G1A = 6400, PC_G1B = 6560, PC_PAD = 6720;
constexpr int DFF = 5632, NUP = 2 * DFF, KL2 = 384, NL2 = 3072;
constexpr int ADA_T0 = 128;
constexpr float NORM_EPS = 1e-6f, GN_EPS = 64e-5f, LOG2E = 1.4426950408889634f;
constexpr float QSCALE = 0.125f * LOG2E;
enum { I_X = 0, I_C, I_RELB, I_WADA, I_BADA, I_NMG, I_WIN, I_QNG, I_KNG, I_LQ1, I_LK1, I_LQ2, I_LK2, I_SUBG, I_MURKV, I_MUWAG, I_W0, I_W1, I_W2, I_A0, I_A1, I_A2, I_G1, I_G2,
       I_KK, I_KA, I_RK, I_LNG, I_LNB, I_WOUT, I_NFG, I_WUP, I_CW, I_CB, I_WDN, N_IN };

constexpr size_t MiB = 1u << 20;
constexpr size_t WS_CTL = 0, CTL_ZERO_BYTES = 64 * 1024;
constexpr size_t WS_MODA = 64 * 1024;
constexpr size_t WS_MOD = 1 * MiB;
constexpr size_t WS_BIASF = 1 * MiB + 256 * 1024;
constexpr size_t WS_ROWSS = 1 * MiB + 512 * 1024;
constexpr size_t WS_ATAB = 1 * MiB + 640 * 1024;
constexpr size_t WS_LAM = 1 * MiB + 704 * 1024;
constexpr size_t WS_GSF = 1 * MiB + 768 * 1024;
constexpr size_t WS_GSM = 1 * MiB + 800 * 1024;
constexpr size_t WS_WDN = 4 * MiB, WS_WUP = 26 * MiB, WS_H = 70 * MiB, WS_WOUT = 134 * MiB, WS_WIN = 142 * MiB, WS_WL2 = 169 * MiB;
constexpr size_t WS_P = 172 * MiB, WS_LA = 388 * MiB, WS_L2 = 400 * MiB, WS_MODP = 496 * MiB;
constexpr size_t WS_X1B = WS_L2;
constexpr size_t WS_OBUF = WS_H, WS_XG = WS_H, WS_ACT = 160 * MiB, WS_UPH = 336 * MiB, WS_HALO = 348 * MiB, WS_END = 512 * MiB;
static_assert(WS_WIN + (size_t)NP * 2048 * 2 <= WS_WL2 && WS_WL2 + (size_t)NL2 * KL2 * 2 <= WS_P && WS_P + (size_t)M * NP * 2 <= WS_LA && WS_LA + (size_t)M * KL2 * 2 <= WS_L2 && WS_L2 + (size_t)M * NL2 * 2 <= WS_MODP, "ws map 1");
static_assert(WS_ACT + (size_t)M * DFF * 2 <= WS_UPH && WS_UPH + (size_t)256 * NUP * 4 <= WS_HALO && WS_HALO + (size_t)256 * NUP * 4 <= WS_END && WS_WUP + (size_t)NUP * 2048 * 2 <= WS_H && WS_WDN + (size_t)2048 * DFF * 2 <= WS_WUP, "ws map 2");
constexpr int CW_BAR = 4096;
constexpr int CW_ATTQ = 64;

constexpr int RING_OFF = 0, RING_BYTES = 131072;
constexpr int LDSCTL_OFF = 143360, MISC_OFF = LDSCTL_OFF + 320;
constexpr int LDS_BYTES = 147456;

struct Frame {
    LAS unsigned char* lds;
    volatile LAS unsigned* MISC;
    gu32* ctl;
    int wave, vcu, G;
    float* out; unsigned char* ws;
};
typedef const float* mk_fptr;
__device__ __forceinline__ const float* inp(int k) {
    const __attribute__((address_space(4))) mk_fptr* t = (const __attribute__((address_space(4))) mk_fptr*)__builtin_amdgcn_kernarg_segment_ptr(); asm volatile("" : "+s"(t));
    return (const float*)(const __attribute__((address_space(1))) float*)t[k];
}
__device__ __forceinline__ float wave_sum(float v) {
#pragma unroll
    for (int o = 1; o < 64; o <<= 1) v += __shfl_xor(v, o);
    return v;
}
__device__ __forceinline__ float bf2f(unsigned short h) { return __uint_as_float((unsigned)h << 16); }
__device__ __forceinline__ float bflo(unsigned w) { return __uint_as_float(w << 16); }
__device__ __forceinline__ float bfhi(unsigned w) { return __uint_as_float(w & 0xffff0000u); }
__device__ __forceinline__ float sigm(float x) { return 1.0f / (1.0f + __expf(-x)); }

__device__ __forceinline__ void transpose_item(const float* W, int ldw, bf16* WT, int ldt, int k0, int n0, int drow0, const float* mu, int smode, LAS float* scr, int lane) {
    const int r8 = lane >> 3, c4 = (lane & 7) * 4; f32x4 v[8];
#pragma unroll
    for (int i = 0; i < 8; ++i) v[i] = *(const GAS f32x4*)(W + (size_t)(k0 + 8 * i + r8) * ldw + n0 + c4);
    if (smode) {
#pragma unroll
        for (int i = 0; i < 8; ++i) { const float m = mu[k0 + 8 * i + r8]; v[i] = v[i] * ((smode == 1) ? (1.0f - m) : m); } }
#pragma unroll
    for (int i = 0; i < 8; ++i) { LAS float* d = scr + (8 * i + r8) * 33 + c4; d[0] = v[i].x; d[1] = v[i].y; d[2] = v[i].z; d[3] = v[i].w; }
    LDS_WAIT(); asm volatile("" ::: "memory");
    const int c = lane & 7;
#pragma unroll
    for (int j = 0; j < 4; ++j) { const int n = (lane >> 3) + 8 * j; const LAS float* s = scr + (8 * c) * 33 + n;
        v4u o; o.x = pk2(s[0 * 33], s[1 * 33]); o.y = pk2(s[2 * 33], s[3 * 33]); o.z = pk2(s[4 * 33], s[5 * 33]); o.w = pk2(s[6 * 33], s[7 * 33]);
        *(GAS v4u*)(WT + (size_t)(drow0 + n) * ldt + k0 + 8 * c) = o; }
    LDS_WAIT(); asm volatile("" ::: "memory");
}
__device__ __forceinline__ int t5_bucket(int n) {
    if (n < 16) return n;
    int large = 16 + (int)(logf((float)n / 16.0f) / logf(8.0f) * 16.0f);
    return large < 31 ? large : 31;
}
__device__ __forceinline__ void p0_prologue(Frame& F) {
    LAS float* scr = (LAS float*)(F.lds + RING_OFF + F.wave * 16384);
    const int gw = F.vcu * NWAVES + F.wave, NGW = F.G * NWAVES, lane = mk_lane_id();
    bf16* WIN_T = (bf16*)(F.ws + WS_WIN); bf16* WOUT_T = (bf16*)(F.ws + WS_WOUT); bf16* WUP_T = (bf16*)(F.ws + WS_WUP); bf16* WDN_T = (bf16*)(F.ws + WS_WDN); bf16* WL2_T = (bf16*)(F.ws + WS_WL2);
    const float* mu_wag = inp(I_MUWAG);
    {
        float* moda = (float*)(F.ws + WS_MODA); const float* wada = inp(I_WADA); const float* c = inp(I_C); const float* bada = inp(I_BADA);
        LAS float* sc = (LAS float*)(F.lds + RING_OFF); LAS float* red = sc + 8192;
        for (int t = F.vcu; t < ADA_T0; t += F.G) {
            for (int i = F.wave * 64 + lane; i < 8192; i += NWAVES * 64) { const float x = c[i]; sc[i] = x * sigm(x); }
            const int rs = lane >> 3, cq = lane & 7; const float* wp = wada + (size_t)(256 * F.wave + rs) * 12288 + 32 * t + 4 * cq;
            f32x4 wv[32];
#pragma unroll
            for (int i = 0; i < 32; ++i) wv[i] = *(const GAS f32x4*)(wp + (size_t)(8 * i) * 12288);
            __syncthreads();
            f32x4 a[4] = {{0.f, 0.f, 0.f, 0.f}, {0.f, 0.f, 0.f, 0.f}, {0.f, 0.f, 0.f, 0.f}, {0.f, 0.f, 0.f, 0.f}};
#pragma unroll
            for (int i = 0; i < 32; ++i) { const int kk = 256 * F.wave + 8 * i + rs;
#pragma unroll
                for (int b = 0; b < 4; ++b) a[b] += wv[i] * sc[b * 2048 + kk]; }
#pragma unroll
            for (int b = 0; b < 4; ++b)
#pragma unroll
                for (int e = 0; e < 4; ++e) { float v = a[b][e]; v += __shfl_xor(v, 8); v += __shfl_xor(v, 16); v += __shfl_xor(v, 32); a[b][e] = v; }
            if (rs == 0) {
#pragma unroll
                for (int b = 0; b < 4; ++b) *(LAS f32x4*)(red + (F.wave * 4 + b) * 32 + 4 * cq) = a[b]; }
            __syncthreads();
            { const int tid = F.wave * 64 + lane; if (tid < 128) { const int b = tid >> 5, cc = tid & 31, col = 32 * t + cc; float s = bada[col];
#pragma unroll
                for (int w = 0; w < 8; ++w) s += red[(w * 4 + b) * 32 + cc];
                moda[b * 4096 + col] = s; } }
            __syncthreads();
        }
    }
    constexpr int I_IN = 32 * 192, I_L = 32 * 2, I_LG = 32 * 5, I_LORA = 4 * I_L + 2 * I_LG, I_OUT = 32 * 64, I_UP = 32 * 352, I_DN = 88 * 64;
    constexpr int NITEMS = I_IN + I_LORA;
    for (int it = gw; it < NITEMS; it += NGW) {
        int r = it;
        if (r < I_IN) { const int kb = r / 192, nb = r % 192, n0 = 32 * nb, blk = n0 >> 10; int drow = (blk == 0 ? PC_Q : blk == 1 ? PC_K : blk == 2 ? PC_V : blk * 1024) + (n0 & 1023);
            if (blk < 2) { const int l = drow & 255; drow = (drow & ~255) + 128 * ((l >> 5) & 1) + 32 * (l >> 6); }
            transpose_item(inp(I_WIN), 6144, WIN_T, 2048, 64 * kb, n0, drow, nullptr, 0, scr, lane); continue; } r -= I_IN;
        if (r < I_LORA) {
            if (r < 2 * I_L) { const int v = r / I_L, q = r % I_L; transpose_item(inp(I_W1), 64, WIN_T, 2048, 64 * (q / 2), 32 * (q % 2), (v ? PC_W1B : PC_W1A) + 32 * (q % 2), mu_wag, 1 + v, scr, lane); continue; } r -= 2 * I_L;
            if (r < 2 * I_L) { const int v = r / I_L, q = r % I_L; transpose_item(inp(I_A1), 64, WIN_T, 2048, 64 * (q / 2), 32 * (q % 2), (v ? PC_A1B : PC_A1A) + 32 * (q % 2), mu_wag + 2048, 1 + v, scr, lane); continue; } r -= 2 * I_L;
            { const int v = r / I_LG, q = r % I_LG; transpose_item(inp(I_G1), 160, WIN_T, 2048, 64 * (q / 5), 32 * (q % 5), (v ? PC_G1B : PC_G1A) + 32 * (q % 5), mu_wag + 4096, 1 + v, scr, lane); continue; }
        } r -= I_LORA;
    }
    const int gt = (F.vcu * NWAVES + F.wave) * 64 + lane, NGT = NGW * 64;
    for (int i = gt; i < (NP - PC_PAD) * 2048 / 8; i += NGT) *(GAS v4u*)(WIN_T + (size_t)PC_PAD * 2048 + (size_t)i * 8) = (v4u){0u, 0u, 0u, 0u};
    const float* w2p = inp(I_W2); const float* a2p = inp(I_A2); const float* g2p = inp(I_G2);
    for (int i = gt; i < NL2 * KL2 / 8; i += NGT) {
        const int n = i % NL2, k0 = (i / NL2) * 8, kind = n >> 10, nl = n & 1023; float v[8] = {0.f, 0.f, 0.f, 0.f, 0.f, 0.f, 0.f, 0.f};
        const float* src = kind == 0 ? w2p : kind == 1 ? a2p - (size_t)64 * 1024 : g2p - (size_t)128 * 1024;
        const int lo = kind == 0 ? 0 : kind == 1 ? 64 : 128, hi = kind == 0 ? 64 : kind == 1 ? 128 : 288;
        if (k0 >= lo && k0 < hi) {
#pragma unroll
            for (int e = 0; e < 8; ++e) v[e] = src[(size_t)(k0 + e) * 1024 + nl]; }
        v4u o; o.x = pk2(v[0], v[1]); o.y = pk2(v[2], v[3]); o.z = pk2(v[4], v[5]); o.w = pk2(v[6], v[7]);
        *(GAS v4u*)(WL2_T + (size_t)n * KL2 + k0) = o;
    }
    { float* rowss = (float*)(F.ws + WS_ROWSS); for (int i = gt; i < M; i += NGT) rowss[i] = 0.f; }
    { float* atab = (float*)(F.ws + WS_ATAB); const float* relb = inp(I_RELB);
        for (int i = gt; i < 8 * 640; i += NGT) { const int h = i / 640, j = i % 640, d = 383 - j;
            atab[i] = d < 0 ? -INFINITY : (relb[t5_bucket(d) * 8 + h] - relb[31 * 8 + h]) * LOG2E; } }
    if (gt == 0) { const float* q1 = inp(I_LQ1); const float* k1 = inp(I_LK1); const float* q2 = inp(I_LQ2); const float* k2 = inp(I_LK2); float s1 = 0.f, s2 = 0.f; for (int i = 0; i < 64; ++i) { s1 += q1[i] * k1[i]; s2 += q2[i] * k2[i]; }
        *(float*)(F.ws + WS_LAM) = expf(s1) - expf(s2) + 0.2f; }
}
typedef float f32x2_lm __attribute__((ext_vector_type(2)));
__device__ __forceinline__ void p3_late_mod(Frame& F, const int q) {
    const int lane = mk_lane_id(), wave = F.wave, col0 = 4096 + 128 * q;
    const float* wada = inp(I_WADA); const float* c = inp(I_C); LAS float* red = (LAS float*)(F.lds + RING_OFF);
    f32x2_lm a0 = {0.f, 0.f}, a1 = a0, a2 = a0, a3 = a0;
    const float* wp = wada + (size_t)(256 * wave) * 12288 + col0 + 2 * lane;
    float cs[4][4];
#pragma unroll
    for (int r = 0; r < 4; ++r)
#pragma unroll
        for (int b = 0; b < 4; ++b) { const float x = c[b * 2048 + 256 * wave + 64 * r + lane]; cs[r][b] = x * sigm(x); }
#pragma unroll
    for (int r = 0; r < 4; ++r) {
#pragma unroll 1
        for (int k0 = 0; k0 < 64; k0 += 16) {
            f32x2_lm wv[16];
#pragma unroll
            for (int i = 0; i < 16; ++i) wv[i] = *(const GAS f32x2_lm*)(wp + (size_t)(64 * r + k0 + i) * 12288);
            asm volatile("" ::: "memory");
#pragma unroll
            for (int i = 0; i < 16; ++i) { const int ln = k0 + i;
                const float s0 = __int_as_float(__builtin_amdgcn_readlane(__float_as_int(cs[r][0]), ln)), s1 = __int_as_float(__builtin_amdgcn_readlane(__float_as_int(cs[r][1]), ln));
                const float s2 = __int_as_float(__builtin_amdgcn_readlane(__float_as_int(cs[r][2]), ln)), s3 = __int_as_float(__builtin_amdgcn_readlane(__float_as_int(cs[r][3]), ln));
                a0 += wv[i] * s0; a1 += wv[i] * s1; a2 += wv[i] * s2; a3 += wv[i] * s3; }
        }
    }
    __syncthreads();
    { LAS f32x2_lm* r2 = (LAS f32x2_lm*)(red + (size_t)wave * 512) + lane; r2[0] = a0; r2[64] = a1; r2[128] = a2; r2[192] = a3; }
    __syncthreads();
    { const int tid = wave * 64 + lane, b = tid >> 7, cc = tid & 127, col = col0 + cc; float s = inp(I_BADA)[col];
#pragma unroll
      for (int p = 0; p < 8; ++p) s += red[p * 512 + b * 128 + cc];
      ((float*)(F.ws + WS_MOD))[(size_t)b * 12288 + col] = s;
      if (col >= 8192 && col < 10240) ((float*)(F.ws + WS_GSF))[b * 2048 + (col - 8192)] = inp(I_NFG)[col - 8192] * (1.0f + s); }
    __syncthreads();
}
__device__ __forceinline__ void p1_hnorm(Frame& F) {
    const int gw = F.vcu * NWAVES + F.wave, NGW = F.G * NWAVES, lane = mk_lane_id();
    const float* moda = (const float*)(F.ws + WS_MODA); const float* nmg = inp(I_NMG); const float* xin = inp(I_X); bf16* H = (bf16*)(F.ws + WS_H);
    const int PPW = (M / 2 + NGW - 1) / NGW; int bcur = -1; f32x4 gg[8], sh[8];
    for (int p = gw * PPW; p < (gw + 1) * PPW && p < M / 2; ++p) {
        const int m = 2 * p, b = m >> 12;
        if (b != bcur) { bcur = b;
#pragma unroll
            for (int j = 0; j < 8; ++j) { const int c = 4 * lane + 256 * j;
                sh[j] = *(const GAS f32x4*)(moda + (size_t)b * 4096 + c);
                gg[j] = *(const GAS f32x4*)(nmg + c) * (1.0f + *(const GAS f32x4*)(moda + (size_t)b * 4096 + 2048 + c)); } }
        const GAS f32x4* xr = (const GAS f32x4*)(xin + (size_t)m * 2048) + lane;
        f32x4 v0[8], v1[8];
#pragma unroll
        for (int j = 0; j < 8; ++j) { v0[j] = xr[64 * j]; v1[j] = xr[512 + 64 * j]; }
        float s0 = 0.f, s1 = 0.f;
#pragma unroll
        for (int j = 0; j < 8; ++j) { s0 += (v0[j].x * v0[j].x + v0[j].y * v0[j].y) + (v0[j].z * v0[j].z + v0[j].w * v0[j].w); s1 += (v1[j].x * v1[j].x + v1[j].y * v1[j].y) + (v1[j].z * v1[j].z + v1[j].w * v1[j].w); }
        const float r0 = 1.0f / sqrtf(wave_sum(s0) * (1.0f / 2048.0f) + NORM_EPS), r1 = 1.0f / sqrtf(wave_sum(s1) * (1.0f / 2048.0f) + NORM_EPS);
        GAS unsigned long long* o8 = (GAS unsigned long long*)(H + (size_t)m * 2048) + lane;
#pragma unroll
        for (int j = 0; j < 8; ++j) { const f32x4 y0 = v0[j] * r0 * gg[j] + sh[j], y1 = v1[j] * r1 * gg[j] + sh[j];
            o8[64 * j] = (unsigned long long)pk2(y0.x, y0.y) | ((unsigned long long)pk2(y0.z, y0.w) << 32);
            o8[512 + 64 * j] = (unsigned long long)pk2(y1.x, y1.y) | ((unsigned long long)pk2(y1.z, y1.w) << 32); }
    }
}
__device__ __forceinline__ void p3_prep(Frame& F) {
    const int gw = F.vcu * NWAVES + F.wave, NGW = F.G * NWAVES, lane = mk_lane_id();
    const bf16* P = (const bf16*)(F.ws + WS_P); bf16* LA = (bf16*)(F.ws + WS_LA);
    const int j0 = 8 * lane; int ca = 0, cb = 0, kind = 3;
    if (j0 < 64) { ca = PC_W1A + j0; cb = PC_W1B + j0; kind = 0; } else if (j0 < 128) { ca = PC_A1A + j0 - 64; cb = PC_A1B + j0 - 64; kind = 1; } else if (j0 < 288) { ca = PC_G1A + j0 - 128; cb = PC_G1B + j0 - 128; kind = 2; }
    const int RPW = (M + NGW - 1) / NGW, mend = (gw + 1) * RPW < M ? (gw + 1) * RPW : M;
    for (int m0 = gw * RPW; m0 < mend; m0 += 4) {
        v4u a[4], b[4];
#pragma unroll
        for (int r = 0; r < 4; ++r) { const int m = m0 + r; a[r] = (v4u){0u, 0u, 0u, 0u}; b[r] = a[r];
            if (m < mend && kind < 3) { a[r] = *(const GAS v4u*)(P + (size_t)m * NP + ca); if ((m & (SEQ - 1)) != 0) b[r] = *(const GAS v4u*)(P + (size_t)(m - 1) * NP + cb); } }
#pragma unroll
        for (int r = 0; r < 4; ++r) { const int m = m0 + r; const float x[8] = {bflo(a[r].x), bfhi(a[r].x), bflo(a[r].y), bfhi(a[r].y), bflo(a[r].z), bfhi(a[r].z), bflo(a[r].w), bfhi(a[r].w)}, y[8] = {bflo(b[r].x), bfhi(b[r].x), bflo(b[r].y), bfhi(b[r].y), bflo(b[r].z), bfhi(b[r].z), bflo(b[r].w), bfhi(b[r].w)}; float o[8];
#pragma unroll
            for (int e = 0; e < 8; ++e) { const float v = x[e] + y[e]; const float s = sigm(kind == 0 ? 2.0f * v : v);
                o[e] = kind == 0 ? 2.0f * s - 1.0f : kind == 1 ? v : kind == 2 ? s : 0.f; }
            if (m < mend && lane < KL2 / 8) { v4u w; w.x = pk2(o[0], o[1]); w.y = pk2(o[2], o[3]); w.z = pk2(o[4], o[5]); w.w = pk2(o[6], o[7]); *(GAS v4u*)(LA + (size_t)m * KL2 + j0) = w; } }
    }
}
template <int CTRL> __device__ __forceinline__ float dpp_mov0(float x) { return __int_as_float(__builtin_amdgcn_update_dpp(0, __float_as_int(x), CTRL, 0xF, 0xF, true)); }
template <int CTRL> __device__ __forceinline__ float dpp_add(float x) { return x + dpp_mov0<CTRL>(x); }
__device__ __forceinline__ float red4(float x) { x = dpp_add<0xB1>(x); x = dpp_add<0x4E>(x); return x; }
constexpr size_t YRAW_OFF = 0, BON_OFF = (size_t)M * 1024 * 4;
__device__ __forceinline__ void unpack8(const v4u w, float* x) { x[0] = bflo(w.x); x[1] = bfhi(w.x); x[2] = bflo(w.y); x[3] = bfhi(w.y); x[4] = bflo(w.z); x[5] = bfhi(w.z); x[6] = bflo(w.w); x[7] = bfhi(w.w); }
__device__ __forceinline__ void ld8f(const float* p, float* x) { const f32x4 a = *(const GAS f32x4*)p, b = *(const GAS f32x4*)(p + 4); x[0] = a.x; x[1] = a.y; x[2] = a.z; x[3] = a.w; x[4] = b.x; x[5] = b.y; x[6] = b.z; x[7] = b.w; }
typedef unsigned v2u __attribute__((ext_vector_type(2)));
typedef short s16x4 __attribute__((ext_vector_type(4)));
constexpr int CK_STR = 144;
constexpr int CK_IMG = 16 * CK_STR;
constexpr int CK_QK = 0, CK_QR = CK_IMG, CK_KB = 2 * CK_IMG, CK_KK = 3 * CK_IMG, CK_V = 4 * CK_IMG, CK_AK = 5 * CK_IMG, CK_BR = CK_AK + 512, CK_KR = CK_BR + 512, CK_TP = CK_KR + 512, CK_GAM = CK_TP + 512, CK_AB = CK_GAM + 256, CK_SLOT = CK_AB + 1024;
constexpr int CK_NSLOT = 8, CK_CONST = CK_NSLOT * CK_SLOT, CK_END = CK_CONST + 8 * 1536;
#ifndef MK_PRE0
#define MK_PRE0 256
#endif
constexpr int CK_IMG_BYTES = 14336, CK_PRE0 = MK_PRE0;
static_assert(CK_END <= 143360, "scan LDS map");
typedef float ck_f32x2 __attribute__((ext_vector_type(2))); typedef __bf16 ck_bf16x2 __attribute__((ext_vector_type(2)));
__device__ __forceinline__ unsigned pk2f(float lo, float hi) { const ck_f32x2 v = {lo, hi}; return __builtin_bit_cast(unsigned, __builtin_convertvector(v, ck_bf16x2)); }
__device__ __forceinline__ void st16bf(LAS unsigned char* p, const float* x) {
    v4u a, b; a.x = pk2f(x[0], x[1]); a.y = pk2f(x[2], x[3]); a.z = pk2f(x[4], x[5]); a.w = pk2f(x[6], x[7]); b.x = pk2f(x[8], x[9]); b.y = pk2f(x[10], x[11]); b.z = pk2f(x[12], x[13]); b.w = pk2f(x[14], x[15]);
    *(LAS v4u*)p = a; *(LAS v4u*)(p + 16) = b;
}
struct CkRaw { v4u r[2], k[2], v[2], rp[2], kp[2], vp[2], lw[2], a[2]; };
__device__ __forceinline__ void ck_fetch(CkRaw& R, const bf16* P, const bf16* L2, const size_t m0, const int c, const int h, const int lane) {
    const int q = lane >> 4, j = lane & 15, ch = h * 64 + 16 * q; const int s = 16 * c + j; const size_t m = m0 + s; const bf16* pr = P + m * NP;
#pragma unroll
    for (int i = 0; i < 2; ++i) { R.r[i] = *(const GAS v4u*)(pr + PC_R + ch + 8 * i); R.k[i] = *(const GAS v4u*)(pr + PC_KR + ch + 8 * i); R.v[i] = *(const GAS v4u*)(pr + PC_VR + ch + 8 * i);
        R.rp[i] = (v4u){0u, 0u, 0u, 0u}; R.kp[i] = R.rp[i]; R.vp[i] = R.rp[i]; }
    if (s > 0) {
#pragma unroll
        for (int i = 0; i < 2; ++i) { R.rp[i] = *(const GAS v4u*)(pr - NP + PC_R + ch + 8 * i); R.kp[i] = *(const GAS v4u*)(pr - NP + PC_KR + ch + 8 * i); R.vp[i] = *(const GAS v4u*)(pr - NP + PC_VR + ch + 8 * i); } }
    const bf16* l2 = L2 + m * NL2;
#pragma unroll
    for (int i = 0; i < 2; ++i) { R.lw[i] = *(const GAS v4u*)(l2 + ch + 8 * i); R.a[i] = *(const GAS v4u*)(l2 + 1024 + ch + 8 * i); }
}
__device__ __forceinline__ void ck_ld16(const LAS float* p, float* x) {
#pragma unroll
    for (int e = 0; e < 4; ++e) { const f32x4 t4 = *(const LAS f32x4*)(p + 4 * e); x[4 * e] = t4.x; x[4 * e + 1] = t4.y; x[4 * e + 2] = t4.z; x[4 * e + 3] = t4.w; }
}
template <int PV = 0> __device__ __forceinline__ void ck_produce(const CkRaw& R, LAS unsigned char* S, const LAS float* CN, float* bonus, const size_t m0, const int c, const int h, const int lane) {
    const int q = lane >> 4, j = lane & 15, c0 = 16 * q; const size_t m = m0 + 16 * c + j;
    float r[16], k[16], v[16], aa[16], lw[16];
    {
        float cur[16], prv[16], mu[16];
#define CK_MIX(dst, CUR, PRV, MUOFF) do { unpack8(CUR[0], cur); unpack8(CUR[1], cur + 8); unpack8(PRV[0], prv); unpack8(PRV[1], prv + 8); ck_ld16(CN + (MUOFF) + c0, mu); \
        _Pragma("unroll") for (int e = 0; e < 16; ++e) dst[e] = cur[e] + (prv[e] - cur[e]) * mu[e]; } while (0)
        CK_MIX(r, R.r, R.rp, 0); CK_MIX(k, R.k, R.kp, 64); CK_MIX(v, R.v, R.vp, 128);
#undef CK_MIX
        unpack8(R.lw[0], lw); unpack8(R.lw[1], lw + 8); unpack8(R.a[0], aa); unpack8(R.a[1], aa + 8);
    }
    const int ro = j * CK_STR + 32 * q;
    st16bf(S + CK_V + ro, v);
    float kap[16], k2[16], bq[16], ss = 0.f, bon = 0.f;
    { float kkc[16]; ck_ld16(CN + 192 + c0, kkc);
#pragma unroll
      for (int e = 0; e < 16; ++e) { kap[e] = k[e] * kkc[e]; ss += kap[e] * kap[e]; } }
    ss += __shfl_xor(ss, 16); ss += __shfl_xor(ss, 32);
    const float inv = __builtin_amdgcn_rcpf(fmaxf(__builtin_amdgcn_sqrtf(ss), 1e-12f));
    { float kac[16], rkc[16]; ck_ld16(CN + 256 + c0, kac); ck_ld16(CN + 320 + c0, rkc);
#pragma unroll
      for (int e = 0; e < 16; ++e) { kap[e] *= inv; k2[e] = k[e] * (1.0f + (aa[e] - 1.0f) * kac[e]); bq[e] = kap[e] * aa[e]; bon += r[e] * k2[e] * rkc[e]; } }
    bon += __shfl_xor(bon, 16); bon += __shfl_xor(bon, 32);
    if (q == 0) bonus[m * 16 + h] = bon;
    unsigned qkw[8], qrw[8], kbw[8], kkw[8];
#pragma unroll
    for (int e2 = 0; e2 < 8; ++e2) {
        float o_qk[2], o_qr[2], o_kb[2], o_kk[2], o_gm[2];
#pragma unroll
        for (int u = 0; u < 2; ++u) { const int e = 2 * e2 + u;
            float G = lw[e]; G += dpp_mov0<0x111>(G); G += dpp_mov0<0x112>(G); G += dpp_mov0<0x114>(G); G += dpp_mov0<0x118>(G);
            const float eR = __expf(G), eK = __builtin_amdgcn_rcpf(eR);
            const float eQ = __int_as_float(__builtin_amdgcn_update_dpp(0x3f800000, __float_as_int(eR), 0x111, 0xF, 0xF, false));
            o_qk[u] = kap[e] * eQ; o_qr[u] = r[e] * eR; o_kb[u] = bq[e] * eK; o_kk[u] = k2[e] * eK; o_gm[u] = eR; }
        qkw[e2] = pk2f(o_qk[0], o_qk[1]); qrw[e2] = pk2f(o_qr[0], o_qr[1]); kbw[e2] = pk2f(o_kb[0], o_kb[1]); kkw[e2] = pk2f(o_kk[0], o_kk[1]);
        if (j == 15) *(LAS ck_f32x2*)(S + CK_GAM + 64 * q + 8 * e2) = (ck_f32x2){o_gm[0], o_gm[1]};
    }
#define CK_ST(OFF, W) do { *(LAS v4u*)(S + (OFF) + ro) = (v4u){W[0], W[1], W[2], W[3]}; *(LAS v4u*)(S + (OFF) + ro + 16) = (v4u){W[4], W[5], W[6], W[7]}; } while (0)
    CK_ST(CK_QK, qkw); CK_ST(CK_QR, qrw); CK_ST(CK_KB, kbw); CK_ST(CK_KK, kkw);
#undef CK_ST
    if (!(PV & 1)) {
        const int t = lane & 15, g = lane >> 4;
        pg8::bf16x8 aQk[2], aQr[2], bKb[2], bKk[2];
#pragma unroll
        for (int sidx = 0; sidx < 2; ++sidx) { const int off = t * CK_STR + (32 * sidx + 8 * g) * 2;
            aQk[sidx] = *(const LAS pg8::bf16x8*)(S + CK_QK + off); aQr[sidx] = *(const LAS pg8::bf16x8*)(S + CK_QR + off); bKb[sidx] = *(const LAS pg8::bf16x8*)(S + CK_KB + off); bKk[sidx] = *(const LAS pg8::bf16x8*)(S + CK_KK + off); }
        f32x4 ab = {0.f, 0.f, 0.f, 0.f}, ak = ab, br = ab, kr = ab;
#pragma unroll
        for (int sidx = 0; sidx < 2; ++sidx) { ab = __builtin_amdgcn_mfma_f32_16x16x32_bf16(aQk[sidx], bKb[sidx], ab, 0, 0, 0); ak = __builtin_amdgcn_mfma_f32_16x16x32_bf16(aQk[sidx], bKk[sidx], ak, 0, 0, 0);
            br = __builtin_amdgcn_mfma_f32_16x16x32_bf16(aQr[sidx], bKb[sidx], br, 0, 0, 0); kr = __builtin_amdgcn_mfma_f32_16x16x32_bf16(aQr[sidx], bKk[sidx], kr, 0, 0, 0); }
        const int jj = lane & 15;
#pragma unroll
        for (int rg = 0; rg < 4; ++rg) { const int tt = 4 * g + rg; const bool lo = jj < tt, le = jj <= tt;
            ((LAS float*)(S + CK_AB))[jj * 16 + tt] = lo ? ab[rg] : 0.f;
            ((LAS unsigned short*)(S + CK_AK))[tt * 16 + jj] = (unsigned short)pk2f(lo ? ak[rg] : 0.f, 0.f);
            ((LAS unsigned short*)(S + CK_BR))[tt * 16 + jj] = (unsigned short)pk2f(le ? br[rg] : 0.f, 0.f);
            ((LAS unsigned short*)(S + CK_KR))[tt * 16 + jj] = (unsigned short)pk2f(le ? kr[rg] : 0.f, 0.f); }
    }
    if (!(PV & 2)) {
        const int cc = lane & 15; const LAS f32x4* A4 = (const LAS f32x4*)(S + CK_AB); float X[16];
#pragma unroll
        for (int tt = 0; tt < 16; ++tt) X[tt] = (tt == cc) ? 1.0f : 0.0f;
#pragma unroll
        for (int jx = 0; jx < 15; ++jx) {
#pragma unroll
            for (int t4 = (jx + 1) / 4; t4 < 4; ++t4) { const f32x4 a4 = A4[jx * 4 + t4];
#pragma unroll
                for (int e = 0; e < 4; ++e) if (4 * t4 + e > jx) X[4 * t4 + e] -= a4[e] * X[jx]; }
        }
        if (lane < 16) {
#pragma unroll
            for (int tt = 0; tt < 16; ++tt) ((LAS unsigned short*)(S + CK_TP))[tt * 16 + cc] = (unsigned short)pk2f(-X[tt], 0.f); }
    }
}
__device__ __forceinline__ pg8::bf16x8 ck_frag(const v2u lo, const v2u hi) { const v4u w = {lo.x, lo.y, hi.x, hi.y}; return __builtin_bit_cast(pg8::bf16x8, w); }
__device__ __forceinline__ v2u ck_tr(const LAS unsigned char* p) { typedef short v4i16_t __attribute__((ext_vector_type(4))); return __builtin_bit_cast(v2u, __builtin_amdgcn_ds_read_tr16_b64_v4i16((LAS v4i16_t*)p)); }
struct CkFrag { v2u vT, aq[2][2], ar[2][2], ak, tp, br, kr, kb[4], kk[4]; f32x4 gm[4]; };
__device__ __forceinline__ void ck_load(CkFrag& Fg, const LAS unsigned char* S, const int w, const int lane) {
    const int t = lane & 15, g = lane >> 4;
    const int trow = (4 * g + ((lane & 15) >> 2)) * CK_STR + (lane & 3) * 8;
    Fg.vT = ck_tr(S + CK_V + trow + 32 * w);
#pragma unroll
    for (int s = 0; s < 2; ++s) { const int off = t * CK_STR + (32 * s + 4 * g) * 2;
        Fg.aq[s][0] = *(const LAS v2u*)(S + CK_QK + off); Fg.aq[s][1] = *(const LAS v2u*)(S + CK_QK + off + 32); Fg.ar[s][0] = *(const LAS v2u*)(S + CK_QR + off); Fg.ar[s][1] = *(const LAS v2u*)(S + CK_QR + off + 32); }
    const int o16 = (t * 16 + 4 * g) * 2;
    Fg.ak = *(const LAS v2u*)(S + CK_AK + o16); Fg.tp = *(const LAS v2u*)(S + CK_TP + o16); Fg.br = *(const LAS v2u*)(S + CK_BR + o16); Fg.kr = *(const LAS v2u*)(S + CK_KR + o16);
#pragma unroll
    for (int kt = 0; kt < 4; ++kt) { Fg.kb[kt] = ck_tr(S + CK_KB + trow + 32 * kt); Fg.kk[kt] = ck_tr(S + CK_KK + trow + 32 * kt); Fg.gm[kt] = *(const LAS f32x4*)(S + CK_GAM + (16 * kt + 4 * g) * 4); }
}
__device__ __forceinline__ void ck_compute(f32x4 (&St)[4], const CkFrag& Fg, float* yo  , const int lane) {
    const int t = lane & 15, g = lane >> 4; const v2u Z = {0u, 0u};
    pg8::bf16x8 bS[2];
#pragma unroll
    for (int s = 0; s < 2; ++s) { const v2u lo = {pk2f(St[2 * s][0], St[2 * s][1]), pk2f(St[2 * s][2], St[2 * s][3])}, hi = {pk2f(St[2 * s + 1][0], St[2 * s + 1][1]), pk2f(St[2 * s + 1][2], St[2 * s + 1][3])}; bS[s] = ck_frag(lo, hi); }
    f32x4 base = {0.f, 0.f, 0.f, 0.f}, y = base;
    base = __builtin_amdgcn_mfma_f32_16x16x32_bf16(ck_frag(Z, Fg.ak), ck_frag(Z, Fg.vT), base, 0, 0, 0);
#pragma unroll
    for (int s = 0; s < 2; ++s) { base = __builtin_amdgcn_mfma_f32_16x16x32_bf16(ck_frag(Fg.aq[s][0], Fg.aq[s][1]), bS[s], base, 0, 0, 0); y = __builtin_amdgcn_mfma_f32_16x16x32_bf16(ck_frag(Fg.ar[s][0], Fg.ar[s][1]), bS[s], y, 0, 0, 0); }
    const v2u bb = {pk2f(base[0], base[1]), pk2f(base[2], base[3])};
    f32x4 u = __builtin_amdgcn_mfma_f32_16x16x32_bf16(ck_frag(Fg.tp, Z), ck_frag(bb, Z), (f32x4){0.f, 0.f, 0.f, 0.f}, 0, 0, 0);
    const v2u ub = {pk2f(u[0], u[1]), pk2f(u[2], u[3])};
    const pg8::bf16x8 bUV = ck_frag(ub, Fg.vT);
#pragma unroll
    for (int kt = 0; kt < 4; ++kt) {
        St[kt] = __builtin_amdgcn_mfma_f32_16x16x32_bf16(ck_frag(Fg.kb[kt], Fg.kk[kt]), bUV, St[kt], 0, 0, 0); }
    y = __builtin_amdgcn_mfma_f32_16x16x32_bf16(ck_frag(Fg.br, Fg.kr), bUV, y, 0, 0, 0);
#pragma unroll
    for (int kt = 0; kt < 4; ++kt) St[kt] = St[kt] * Fg.gm[kt];
#pragma unroll
    for (int rg = 0; rg < 4; ++rg) yo[(size_t)(4 * g + rg) * 1024 + t] = y[rg];
}
__device__ __forceinline__ unsigned char* ck_image_base(Frame& F, const int head) {
    constexpr size_t HB = (size_t)128 * CK_IMG_BYTES;
    if (head < 36) return (unsigned char*)F.out + 65 * MiB + (size_t)head * HB;
    if (head < 51) return F.ws + WS_WIN + (size_t)(head - 36) * HB;
    if (head < 60) return F.ws + WS_MODP + (size_t)(head - 51) * HB;
    return F.ws + WS_LA + (size_t)(head - 60) * HB;
}
static_assert((size_t)15 * 128 * CK_IMG_BYTES <= 27 * MiB && (size_t)9 * 128 * CK_IMG_BYTES <= 16 * MiB && (size_t)4 * 128 * CK_IMG_BYTES <= 12 * MiB && 65 * MiB + (size_t)36 * 128 * CK_IMG_BYTES <= 128 * MiB, "chunk image parking");
template <int PV = 0> __device__ __forceinline__ void p5a_preproduce(Frame& F) {
    const int lane = mk_lane_id(), wave = F.wave; const int gw = F.vcu * NWAVES + wave, NGW = F.G * NWAVES;
    LAS unsigned char* L = F.lds; LAS unsigned char* S = L + wave * CK_SLOT; LAS float* CN = (LAS float*)(L + CK_CONST + wave * 1536);
    const bf16* P = (const bf16*)(F.ws + WS_P); const bf16* L2 = (const bf16*)(F.ws + WS_L2); float* bonus = (float*)((unsigned char*)F.out + BON_OFF);
    const float* murkv = inp(I_MURKV); const float* pkk = inp(I_KK); const float* pka = inp(I_KA); const float* prk = inp(I_RK);
    constexpr int NPRE = CK_PRE0 < 256 ? 256 - CK_PRE0 : 1;
    for (int task = gw; task < 64 * (256 - CK_PRE0); task += NGW) {
        const int head = task / NPRE, c = CK_PRE0 + task % NPRE, b = head >> 4, h = head & 15; const size_t m0 = (size_t)b * SEQ;
#pragma unroll
        for (int i = 0; i < 6; ++i) { const float* src = i < 3 ? murkv + i * 1024 : i == 3 ? pkk : i == 4 ? pka : prk; CN[i * 64 + lane] = src[h * 64 + lane]; }
        CkRaw R; ck_fetch(R, P, L2, m0, c, h, lane);
        ck_produce<PV>(R, S, CN, bonus, m0, c, h, lane);
        unsigned char* dst = ck_image_base(F, head) + (size_t)(c - CK_PRE0) * CK_IMG_BYTES;
#pragma unroll
        for (int i = 0; i < CK_IMG_BYTES / 1024; ++i) *(GAS v4u*)(dst + i * 1024 + lane * 16) = *(const LAS v4u*)(S + i * 1024 + lane * 16);
    }
}
#define CK_BARRIER() asm volatile("s_waitcnt lgkmcnt(0)\n\ts_barrier" ::: "memory")
template <int VAR = 0> __device__ __forceinline__ void p5_rwkv_scan(Frame& F, const int sidx) {
    const int lane = mk_lane_id(), wave = F.wave, b = sidx >> 4, h = sidx & 15;
    LAS unsigned char* L = F.lds; const bf16* P = (const bf16*)(F.ws + WS_P); const bf16* L2 = (const bf16*)(F.ws + WS_L2);
    float* yraw = (float*)((unsigned char*)F.out + YRAW_OFF); float* bonus = (float*)((unsigned char*)F.out + BON_OFF);
    const size_t m0 = (size_t)b * SEQ; constexpr int NI = SEQ / (16 * CK_NSLOT);
    LAS float* CN = (LAS float*)(L + CK_CONST);
    { const int tid = wave * 64 + lane; if (tid < 384) { const int a = tid >> 6, cc = tid & 63; const float* src = a < 3 ? inp(I_MURKV) + a * 1024 : a == 3 ? inp(I_KK) : a == 4 ? inp(I_KA) : inp(I_RK); CN[tid] = src[h * 64 + cc]; } }
    f32x4 St[4];
#pragma unroll
    for (int kt = 0; kt < 4; ++kt) St[kt] = (f32x4){0.f, 0.f, 0.f, 0.f};
    CkRaw R; ck_fetch(R, P, L2, m0, wave, h, lane);
    __syncthreads();
    const unsigned char* img = ck_image_base(F, sidx);
    for (int it = 0; it < NI; ++it) {
        if (CK_NSLOT * it < CK_PRE0) {
            if (!(VAR & 2)) ck_produce<(VAR >> 2) & 3>(R, L + wave * CK_SLOT, CN, bonus, m0, CK_NSLOT * it + wave, h, lane);
            if (CK_NSLOT * (it + 1) < CK_PRE0) ck_fetch(R, P, L2, m0, CK_NSLOT * (it + 1) + wave, h, lane);
        } else {
            const unsigned char* src = img + (size_t)(CK_NSLOT * it + wave - CK_PRE0) * CK_IMG_BYTES + lane * 16; const unsigned dstl = (unsigned)(uintptr_t)(L + wave * CK_SLOT);
#pragma unroll
            for (int i = 0; i < CK_IMG_BYTES / 1024; ++i) attn_body::glds16(src + i * 1024, (unsigned)__builtin_amdgcn_readfirstlane(dstl + i * 1024));
            asm volatile("s_waitcnt vmcnt(0)" ::: "memory");
        }
        CK_BARRIER();
        if (wave < 4 && !(VAR & 1)) {
            float* yo = yraw + (m0 + (size_t)(CK_NSLOT * it) * 16) * 1024 + h * 64 + 16 * wave;
            CkFrag FA, FB; ck_load(FA, L, wave, lane);
#pragma unroll
            for (int cc = 0; cc < CK_NSLOT; cc += 2) {
                ck_load(FB, L + (cc + 1) * CK_SLOT, wave, lane); ck_compute(St, FA, yo + (size_t)cc * 16 * 1024, lane);
                if (cc + 2 < CK_NSLOT) ck_load(FA, L + (cc + 2) * CK_SLOT, wave, lane);
                ck_compute(St, FB, yo + (size_t)(cc + 1) * 16 * 1024, lane);
            }
        }
        CK_BARRIER();
    }
}
constexpr int CV_OUT = 32 * 64, CV_UP = 32 * 352, CV_DN = 88 * 64, CV_UNITS = (CV_OUT + CV_UP + CV_DN) / 64;
static_assert((CV_OUT + CV_UP + CV_DN) % 64 == 0 && CV_UNITS == 296, "conversion units");
__device__ __forceinline__ void conv_unit(Frame& F, const int cid) {
    const int lane = mk_lane_id(); LAS float* scr = (LAS float*)(F.lds + RING_OFF + F.wave * 8704);
    bf16* WOUT_T = (bf16*)(F.ws + WS_WOUT); bf16* WUP_T = (bf16*)(F.ws + WS_WUP); bf16* WDN_T = (bf16*)(F.ws + WS_WDN);
#pragma unroll 1
    for (int j = 0; j < 8; ++j) { int r = cid * 64 + F.wave * 8 + j;
        if (r < CV_OUT) { transpose_item(inp(I_WOUT), 2048, WOUT_T, 2048, 64 * (r / 64), 32 * (r % 64), 32 * (r % 64), nullptr, 0, scr, lane); continue; } r -= CV_OUT;
        if (r < CV_UP) { const int n0 = 32 * (r % 352), bj = n0 >= DFF, rr = n0 - bj * DFF;
            transpose_item(inp(I_WUP), NUP, WUP_T, 2048, 64 * (r / 352), n0, 256 * (rr >> 7) + 128 * bj + (rr & 127), nullptr, 0, scr, lane); continue; } r -= CV_UP;
        transpose_item(inp(I_WDN), 2048, WDN_T, DFF, 64 * (r / 64), 32 * (r % 64), 32 * (r % 64), nullptr, 0, scr, lane); }
}
__device__ __forceinline__ void p6_queue(Frame& F, const attn_body::AttnArgs& T) {
    volatile LAS unsigned* slot = F.MISC + 16; const int wid = F.wave; char* lds = (char*)(unsigned char*)F.lds;
    constexpr int NLATE = 64, NPAIR = 512, NU = NPAIR + CV_UNITS + NLATE;
    static_assert(CV_UNITS <= NPAIR, "interleave");
    static_assert(8 * 8704 <= attn_body::LDS_TAB && attn_body::LDS_BYTES <= attn_body::LDS_TAB && attn_body::LDS_TAB + 8 * attn_body::TAB_N * 4 <= LDSCTL_OFF, "phase-6 LDS map");
    { const int lane = mk_lane_id(); LAS float* tl = (LAS float*)(F.lds + attn_body::LDS_TAB);
      for (int i = wid * 64 + lane; i < 8 * attn_body::TAB_N; i += 512) tl[i] = T.tab[i];
      if (wid == 0 && lane == 0) { const unsigned u = __hip_atomic_fetch_add(T.qctr, 1u, __ATOMIC_RELAXED, __HIP_MEMORY_SCOPE_AGENT); slot[0] = u; } }
    asm volatile("s_waitcnt vmcnt(0) lgkmcnt(0)\n\ts_barrier" ::: "memory");
    const float* lamp = (const float*)(F.ws + WS_LAM); const float* subg = inp(I_SUBG); attn_body::bf16* PQ = (attn_body::bf16*)(F.ws + WS_P);
    for (;;) {
        const int u0 = __builtin_amdgcn_readfirstlane((int)slot[0]);
        if (u0 >= NU) break;
        const int u = u0 - NLATE;
        if (u < 0 || (u < 2 * CV_UNITS && (u & 1) == 1)) {
            if (u < 0) p3_late_mod(F, u0); else conv_unit(F, u >> 1);
            asm volatile("s_waitcnt lgkmcnt(0)\n\ts_barrier" ::: "memory");
            if (wid == 0 && mk_lane_id() == 0) { const unsigned n = __hip_atomic_fetch_add(T.qctr, 1u, __ATOMIC_RELAXED, __HIP_MEMORY_SCOPE_AGENT); slot[0] = n; }
            asm volatile("s_waitcnt vmcnt(0) lgkmcnt(0)\n\ts_barrier" ::: "memory");
            continue; }
        const int idx = u < 2 * CV_UNITS ? (u >> 1) : u - CV_UNITS;
        const int qb = (int)((0x123486957abcdefull >> (4 * (idx >> 5))) & 15ull), sg = idx & 31, b = sg >> 3, h = sg & 7;
#pragma unroll 1
        for (int ih = 0; ih < 2; ++ih) {
            const int qcol = 2048 + h * 128 + ih * 64, kcol = h * 128 + ih * 64, vcol = 1024 + h * 128, ocol = h * 256;
            attn_body::attn_unit<8>(b, qcol, kcol, vcol, ocol, qb, T.P, T.O, lds, wid, h * attn_body::TAB_N, T.qctr, slot, ih == 1, PQ, PC_Q + h * 128, lamp, subg);
        }
    }
}
__device__ __forceinline__ void p6_combine(Frame& F) {
    const int gw = F.vcu * NWAVES + F.wave, NGW = F.G * NWAVES, lane = mk_lane_id();
    {
    const bf16* WUP_T = (const bf16*)(F.ws + WS_WUP); const float* mod = (const float*)(F.ws + WS_MOD); float* biasf = (float*)(F.ws + WS_BIASF);
    float shv[4][4][8];
#pragma unroll
    for (int b = 0; b < 4; ++b)
#pragma unroll
        for (int it = 0; it < 4; ++it) ld8f(mod + (size_t)b * 12288 + 6144 + it * 512 + lane * 8, shv[b][it]);
    for (int col = gw; col < NUP; col += NGW) { float a[4] = {0.f, 0.f, 0.f, 0.f};
#pragma unroll
        for (int it = 0; it < 4; ++it) { const int k0 = it * 512 + lane * 8; const v4u w = *(const GAS v4u*)(WUP_T + (size_t)col * 2048 + k0);
            const float x[8] = {bflo(w.x), bfhi(w.x), bflo(w.y), bfhi(w.y), bflo(w.z), bfhi(w.z), bflo(w.w), bfhi(w.w)};
#pragma unroll
            for (int b = 0; b < 4; ++b) {
#pragma unroll
                for (int e = 0; e < 8; ++e) a[b] += x[e] * shv[b][it][e]; } }
        const int lcol = ((col >> 7) & 1) * DFF + (col >> 8) * 128 + (col & 127);
#pragma unroll
        for (int b = 0; b < 4; ++b) { const float s = wave_sum(a[b]); if (lane == 0) biasf[(size_t)b * NUP + lcol] = s; }
    }
    }
    bf16* P = (bf16*)(F.ws + WS_P);
    const int hh = lane >> 2, chn = hh * 64 + (lane & 3) * 16;
    const float* yraw = (const float*)((const unsigned char*)F.out + YRAW_OFF); const float* bonus = (const float*)((const unsigned char*)F.out + BON_OFF); const bf16* L2 = (const bf16*)(F.ws + WS_L2);
    float muv[16], lng[16], lnb[16];
    { const float* pm = inp(I_MURKV) + 2048 + chn; const float* pg = inp(I_LNG) + chn; const float* pb = inp(I_LNB) + chn; ld8f(pm, muv); ld8f(pm + 8, muv + 8); ld8f(pg, lng); ld8f(pg + 8, lng + 8); ld8f(pb, lnb); ld8f(pb + 8, lnb + 8); }
    struct TokIn { f32x4 y[4]; v4u va, vb, pa, pb2, ga, gb; float bon; };
    auto ldtok = [&](const int m, TokIn& T) {
        const float* yp = yraw + (size_t)m * 1024 + chn;
#pragma unroll
        for (int i = 0; i < 4; ++i) T.y[i] = *(const GAS f32x4*)(yp + 4 * i);
        const bf16* pr = P + (size_t)m * NP + PC_VR + chn; const bf16* pp = ((m & (SEQ - 1)) != 0) ? pr - NP : pr;
        T.va = *(const GAS v4u*)pr; T.vb = *(const GAS v4u*)(pr + 8); T.pa = *(const GAS v4u*)pp; T.pb2 = *(const GAS v4u*)(pp + 8);
        T.ga = *(const GAS v4u*)(L2 + (size_t)m * NL2 + 2048 + chn); T.gb = *(const GAS v4u*)(L2 + (size_t)m * NL2 + 2048 + chn + 8);
        T.bon = bonus[(size_t)m * 16 + hh]; };
    auto fintok = [&](const int m, const TokIn& T) {
        {
            float y[16] = {T.y[0].x, T.y[0].y, T.y[0].z, T.y[0].w, T.y[1].x, T.y[1].y, T.y[1].z, T.y[1].w, T.y[2].x, T.y[2].y, T.y[2].z, T.y[2].w, T.y[3].x, T.y[3].y, T.y[3].z, T.y[3].w};
            const float hpm = ((m & (SEQ - 1)) != 0) ? 1.0f : 0.0f;
            float vp[16], vq[16], gg[16]; unpack8(T.va, vp); unpack8(T.vb, vp + 8); unpack8(T.pa, vq); unpack8(T.pb2, vq + 8); unpack8(T.ga, gg); unpack8(T.gb, gg + 8);
            float s1 = 0.f;
#pragma unroll
            for (int e = 0; e < 16; ++e) s1 += y[e];
            s1 = red4(s1); const float mu = s1 * (1.0f / 64.0f); float s2 = 0.f;
#pragma unroll
            for (int e = 0; e < 16; ++e) { y[e] -= mu; s2 += y[e] * y[e]; }
            s2 = red4(s2); const float rs = 1.0f / sqrtf(s2 * (1.0f / 64.0f) + GN_EPS); float o[16];
#pragma unroll
            for (int e = 0; e < 16; ++e) { const float v = vp[e] + (hpm * vq[e] - vp[e]) * muv[e]; o[e] = (y[e] * rs * lng[e] + lnb[e] + T.bon * v) * gg[e]; }
            bf16* dr = P + (size_t)m * NP + PC_R + chn;
            v4u w0, w1; w0.x = pk2(o[0], o[1]); w0.y = pk2(o[2], o[3]); w0.z = pk2(o[4], o[5]); w0.w = pk2(o[6], o[7]); w1.x = pk2(o[8], o[9]); w1.y = pk2(o[10], o[11]); w1.z = pk2(o[12], o[13]); w1.w = pk2(o[14], o[15]);
            *(GAS v4u*)dr = w0; *(GAS v4u*)(dr + 8) = w1;
        }
    };
    for (int m = gw; m < M; m += 2 * NGW) { const int m2 = m + NGW; const bool two = m2 < M; TokIn A, B; ldtok(m, A); ldtok(two ? m2 : m, B); fintok(m, A); if (two) fintok(m2, B); }
}
__device__ __forceinline__ void fixup_tile(Frame& F, const int pm) {
    const int tid = F.wave * 64 + mk_lane_id();
    const float* uph = (const float*)(F.ws + WS_UPH); const float* halo = (const float*)(F.ws + WS_HALO); bf16* ACT = (bf16*)(F.ws + WS_ACT);
    const float* cw = inp(I_CW); const float* cb = inp(I_CB);
    for (int it = tid; it < 4 * (DFF / 8); it += NWAVES * 64) {
        const int j0 = (it % (DFF / 8)) * 8, k = (it / (DFF / 8)) & 1, blk = 2 * pm + it / (2 * (DFF / 8)); const bool seq0 = ((blk * 128) & (SEQ - 1)) == 0;
        const float m1 = (k == 0 && seq0) ? 0.f : 1.f, m2 = seq0 ? 0.f : 1.f;
        const float* p1 = (k == 1 || seq0) ? uph + (size_t)(blk * 2) * NUP : halo + (size_t)((blk - 1) * 2 + 1) * NUP;
        const float* p2 = seq0 ? uph + (size_t)(blk * 2 + k) * NUP : halo + (size_t)((blk - 1) * 2 + k) * NUP;
        float yy[2][8];
#pragma unroll
        for (int hv = 0; hv < 2; ++hv) { const int c = hv * DFF + j0; float u0[8], u1[8], u2[8], w0[8], w1[8], w2[8], bb[8];
            ld8f(uph + (size_t)(blk * 2 + k) * NUP + c, u0); ld8f(p1 + c, u1); ld8f(p2 + c, u2);
            ld8f(cw + c, w0); ld8f(cw + NUP + c, w1); ld8f(cw + 2 * NUP + c, w2); ld8f(cb + c, bb);
#pragma unroll
            for (int e = 0; e < 8; ++e) yy[hv][e] = bb[e] + w0[e] * (m2 * u2[e]) + w1[e] * (m1 * u1[e]) + w2[e] * u0[e]; }
        float o[8];
#pragma unroll
        for (int e = 0; e < 8; ++e) o[e] = yy[0][e] * sigm(yy[0][e]) * yy[1][e];
        v4u w; w.x = pk2(o[0], o[1]); w.y = pk2(o[2], o[3]); w.z = pk2(o[4], o[5]); w.w = pk2(o[6], o[7]);
        *(GAS v4u*)(ACT + (size_t)(blk * 128 + k) * DFF + j0) = w;
    }
}

#ifndef MK_N_LAUNCHES
#define MK_N_LAUNCHES 1
#endif
constexpr int NPHASE = 11;
__device__ __forceinline__ int mk_opq(int v) { asm volatile("" : "+s"(v)); return v; }
constexpr int N_LAUNCHES = MK_N_LAUNCHES;
struct Args { const float* in[N_IN]; float* out; unsigned char* ws; int ph_lo, ph_hi; };
__global__ void __launch_bounds__(NWAVES * 64, 2) mk_fwd(Args args) {
    extern __shared__ __attribute__((aligned(16))) unsigned char lds[];
    Frame F;
    F.lds = (LAS unsigned char*)lds;
    F.MISC = (volatile LAS unsigned*)(F.lds + MISC_OFF);
    F.wave = __builtin_amdgcn_readfirstlane((int)threadIdx.x >> 6);
    F.G = gridDim.x; { const int bx = blockIdx.x; F.vcu = (F.G % 8 == 0) ? (bx % 8) * (F.G / 8) + bx / 8 : bx; }
    F.ws = args.ws; F.out = args.out; F.ctl = (gu32*)(args.ws + WS_CTL);
    for (int u = F.wave * 64 + mk_lane_id(); u < (LDS_BYTES - LDSCTL_OFF) / 4; u += NWAVES * 64) ((LAS unsigned*)(F.lds + LDSCTL_OFF))[u] = 0u;
    __syncthreads();
    XcdBarrier bar; bar.bar = (unsigned*)(F.ctl + CW_BAR); bar.x = 0; bar.st = nullptr;
    if (N_LAUNCHES == 1) bar = xcd_barrier_post((unsigned*)(F.ctl + CW_BAR), F.MISC + 8, F.wave == 0 && mk_lane_id() == 0);
    const int lo = args.ph_lo, hi = args.ph_hi;
#define IN(k) (lo <= (k) && (k) < hi)
#ifndef PROBE_MASK
#define PROBE_MASK 0
#endif
#ifndef PROBE_NREP
#define PROBE_NREP 2
#endif
#define REP(k) for (int rep_ = 0; rep_ < (((PROBE_MASK >> (k)) & 1) ? PROBE_NREP : 1); ++rep_)
#define SEAM(k) do { if (IN(k) && IN((k) + 1)) xcd_barrier(bar, F.wave == 0 && mk_lane_id() == 0); } while (0)
    unsigned char* ws = args.ws;
    bf16* H = (bf16*)(ws + WS_H); bf16* P = (bf16*)(ws + WS_P); bf16* LA = (bf16*)(ws + WS_LA); bf16* L2 = (bf16*)(ws + WS_L2);
    float* mod = (float*)(ws + WS_MOD);

    if (IN(0)) { REP(0) p0_prologue(F); } SEAM(0);
    if (IN(2)) { REP(2) p1_hnorm(F); } SEAM(2);
    if (IN(3)) REP(3) {
        pg8::Gemm g{H, H, 1 << 30, 2048, (const bf16*)(ws + WS_WIN), M, NP, 2048}; pg8::StaticOrder S; S.init(M, NP, F.G, (int)blockIdx.x);
        pg8::EpiStoreQK E{P, NP, inp(I_QNG), inp(I_KNG), QSCALE};
        pg8::gemm_phase<pg8::EpiStoreQK, pg8::StaticOrder, true, true>(F.lds + RING_OFF, g, S, E, F.wave);
    } SEAM(3);
    if (IN(4)) { p3_prep(F); } SEAM(4);
    if (IN(5)) REP(5) {
        int kw = 256, kw2 = 128; asm volatile("" : "+s"(kw), "+s"(kw2));
        pg8::Gemm g{LA, LA, 1 << 30, KL2, (const bf16*)(ws + WS_WL2), M, NL2, kw, KL2, 8, 128, kw2}; pg8::StaticOrder S; S.init(M, NL2, F.G, (int)blockIdx.x);
        pg8::EpiLora2 E{L2, inp(I_W0), inp(I_A0)};
        pg8::gemm_phase<pg8::EpiLora2, pg8::StaticOrder, true, true>(F.lds + RING_OFF, g, S, E, F.wave);
    } SEAM(5);
#ifdef PROBE6N
    if (IN(6)) for (;;) {
        if (__builtin_amdgcn_readfirstlane((int)F.MISC[24]) > 0) xcd_barrier(bar, F.wave == 0 && mk_lane_id() == 0);
        if (CK_PRE0 < 256) { p5a_preproduce(F); xcd_barrier(bar, F.wave == 0 && mk_lane_id() == 0); }
        for (int hd = F.vcu; hd < 64; hd += F.G) p5_rwkv_scan(F, hd);
        { const int rq = __builtin_amdgcn_readfirstlane((int)F.MISC[24]);
          const attn_body::AttnArgs AT{(const attn_body::bf16*)P, (attn_body::bf16*)(ws + WS_OBUF), (const float*)(ws + WS_ATAB), (unsigned*)(F.ctl + CW_ATTQ + 64 * rq)};
          p6_queue(F, AT); }
        __syncthreads(); const int r1 = __builtin_amdgcn_readfirstlane((int)F.MISC[24]) + 1; __syncthreads();
        if (F.wave == 0 && mk_lane_id() == 0) F.MISC[24] = (unsigned)r1;
        __syncthreads(); if (r1 >= PROBE6N) break;
    } SEAM(6);
#else
    if (IN(6)) REP(6) {
#ifdef PROBE_SCANX
        { if (F.G >= 64) { const int hd = (F.vcu * 64) / F.G; if (F.vcu == 0 || ((F.vcu - 1) * 64) / F.G != hd) p5_rwkv_scan<PROBE_SCANX>(F, hd); }
          xcd_barrier(bar, F.wave == 0 && mk_lane_id() == 0); }
#endif
        if (CK_PRE0 < 256) { p5a_preproduce(F);
        xcd_barrier(bar, F.wave == 0 && mk_lane_id() == 0); }
        for (int hd = F.vcu; hd < 64; hd += F.G) p5_rwkv_scan(F, hd);
        const attn_body::AttnArgs AT{(const attn_body::bf16*)P, (attn_body::bf16*)(ws + WS_OBUF), (const float*)(ws + WS_ATAB), (unsigned*)(F.ctl + CW_ATTQ + 64 * rep_)};
        p6_queue(F, AT);
#ifdef PROBE_CONV2
        for (int cid = F.vcu; cid < CV_UNITS; cid += F.G) conv_unit(F, cid);
#endif
    } SEAM(6);
#endif
    if (IN(7)) { REP(7) p6_combine(F); } SEAM(7);
    if (IN(8)) {
        pg8::Gemm g{P + PC_Q, P + PC_Q, 1 << 30, NP, (const bf16*)(ws + WS_WOUT), M, 2048, 2048}; pg8::StaticOrder S; S.init(M, 2048, F.G, (int)blockIdx.x);
        pg8::EpiOut E{inp(I_X), (bf16*)(ws + WS_X1B), (bf16*)(ws + WS_XG), (float*)(ws + WS_ROWSS), mod + 4096, (const float*)(ws + WS_GSF), 12288};
        pg8::gemm_phase<pg8::EpiOut, pg8::StaticOrder, true, true>(F.lds + RING_OFF, g, S, E, F.wave);
    } SEAM(8);
#ifdef PROBE_UPPLAIN
    if (IN(9)) {
        const bf16* XG = (const bf16*)(ws + WS_XG);
        pg8::Gemm g{XG, XG, 1 << 30, 2048, (const bf16*)(ws + WS_WUP), M, NUP, 2048}; pg8::StaticOrder S; S.init(M, NUP, F.G, (int)blockIdx.x);
        pg8::EpiStore E{(bf16*)(ws + 160 * MiB), NUP};
        pg8::gemm_phase<pg8::EpiStore, pg8::StaticOrder, true, true>(F.lds + RING_OFF, g, S, E, F.wave);
    }
#endif
    if (IN(9)) REP(9) {
        const bf16* XG = (const bf16*)(ws + WS_XG);
        pg8::Gemm g{XG, XG, 1 << 30, 2048, (const bf16*)(ws + WS_WUP), M, NUP, 2048}; pg8::StaticOrder S; S.init(M, NUP, F.G, (int)blockIdx.x);
        pg8::EpiUpGlu E{(bf16*)(ws + WS_ACT), (const float*)(ws + WS_ROWSS), (const float*)(ws + WS_BIASF), inp(I_CW), inp(I_CB), (float*)(ws + WS_UPH), (float*)(ws + WS_HALO)};
        pg8::gemm_phase<pg8::EpiUpGlu, pg8::StaticOrder, true, true>(F.lds + RING_OFF, g, S, E, F.wave);
    } SEAM(9);
    if (IN(10)) {
        const bf16* ACT = (const bf16*)(ws + WS_ACT);
        pg8::Gemm g{ACT, ACT, 1 << 30, DFF, (const bf16*)(ws + WS_WDN), M, 2048, DFF}; pg8::StaticOrder S; S.init(M, 2048, F.G, (int)blockIdx.x);
        { pg8::Unit u; int last = -1; for (int i = 0; S.next(i, u); ++i) { if (u.pm != last) fixup_tile(F, u.pm); last = u.pm; } }
        asm volatile("s_waitcnt vmcnt(0)" ::: "memory"); __syncthreads();
        pg8::EpiDown E{F.out, (const bf16*)(ws + WS_X1B), mod + 10240, 12288};
        pg8::gemm_phase<pg8::EpiDown, pg8::StaticOrder, true, true>(F.lds + RING_OFF, g, S, E, F.wave);
    }
#undef IN
#undef SEAM
}

extern "C" void kernel_launch(void* const* d_in, const int* in_sizes, int n_in, void* d_out, int out_size, void* d_ws, size_t ws_size, hipStream_t stream) {
    static int grid = 0;
    if (grid == 0) {
        if (n_in != N_IN || in_sizes[0] != M * DMODEL || out_size != M * DMODEL || ws_size < WS_END) {
            fprintf(stderr, "kernel_launch: shape/workspace mismatch: n_in %d in0 %d out %d ws %zu (need %zu); nothing launched\n", n_in, n_in > 0 ? in_sizes[0] : -1, out_size, ws_size, (size_t)WS_END); grid = -1; return; }
        int dev = 0, cus = 0, per_cu = 0;
        if (hipGetDevice(&dev) != hipSuccess || hipDeviceGetAttribute(&cus, hipDeviceAttributeMultiprocessorCount, dev) != hipSuccess) { fprintf(stderr, "kernel_launch: device query failed\n"); grid = -1; return; }
        if (hipFuncSetAttribute((const void*)mk_fwd, hipFuncAttributeMaxDynamicSharedMemorySize, LDS_BYTES) != hipSuccess) { fprintf(stderr, "kernel_launch: hipFuncSetAttribute failed\n"); grid = -1; return; }
        if (hipOccupancyMaxActiveBlocksPerMultiprocessor(&per_cu, (const void*)mk_fwd, NWAVES * 64, LDS_BYTES) != hipSuccess || per_cu < 1) { fprintf(stderr, "kernel_launch: occupancy query says %d blocks per CU\n", per_cu); per_cu = 1; }
        (void)hipGetLastError();
        grid = cus;
        if (grid % 8 != 0 || grid < 64) fprintf(stderr, "kernel_launch: unexpected CU count %d\n", grid);
    }
    if (grid < 0) return;
    (void)hipMemsetAsync((char*)d_ws + WS_CTL, 0, CTL_ZERO_BYTES, stream);
    Args a{};
    for (int i = 0; i < N_IN; ++i) a.in[i] = (const float*)d_in[i];
    a.out = (float*)d_out; a.ws = (unsigned char*)d_ws;
#ifdef PROBE_RN
    if (PROBE_RLO > 0) { a.ph_lo = 0; a.ph_hi = PROBE_RLO; hipLaunchKernelGGL(mk_fwd, dim3(grid), dim3(NWAVES * 64), LDS_BYTES, stream, a); }
    for (int r = 0; r < PROBE_RN; ++r) { (void)hipMemsetAsync((char*)d_ws + WS_CTL, 0, CTL_ZERO_BYTES, stream); a.ph_lo = PROBE_RLO; a.ph_hi = PROBE_RHI; hipLaunchKernelGGL(mk_fwd, dim3(grid), dim3(NWAVES * 64), LDS_BYTES, stream, a); }
    (void)hipMemsetAsync((char*)d_ws + WS_CTL, 0, CTL_ZERO_BYTES, stream); a.ph_lo = PROBE_RHI; a.ph_hi = NPHASE; hipLaunchKernelGGL(mk_fwd, dim3(grid), dim3(NWAVES * 64), LDS_BYTES, stream, a);
    if (false)
#endif
    if (N_LAUNCHES == 1) { a.ph_lo = 0; a.ph_hi = NPHASE; hipLaunchKernelGGL(mk_fwd, dim3(grid), dim3(NWAVES * 64), LDS_BYTES, stream, a); }
    else for (int li = 0; li < NPHASE; ++li) { a.ph_lo = li; a.ph_hi = li + 1; hipLaunchKernelGGL(mk_fwd, dim3(grid), dim3(NWAVES * 64), LDS_BYTES, stream, a); }
    const hipError_t le = hipPeekAtLastError();
    if (le != hipSuccess) fprintf(stderr, "kernel_launch: launch failed: %s\n", hipGetErrorName(le));
}
```

```cpp
#include <hip/hip_runtime.h>
#include <hip/hip_bf16.h>
#include <cstdio>
#include <cstdint>
#include <cmath>
__device__ __forceinline__ int mk_lane_id() { int l; asm volatile("v_mbcnt_lo_u32_b32 %0, -1, 0\n\tv_mbcnt_hi_u32_b32 %0, -1, %0" : "=v"(l)); return l; }
namespace pg8 {
#define PG8_LAS __attribute__((address_space(3)))
typedef unsigned short bf16_t;
typedef short bf16x8 __attribute__((ext_vector_type(8)));
typedef float f32x4 __attribute__((ext_vector_type(4)));
typedef unsigned u32x4 __attribute__((ext_vector_type(4)));
constexpr int BM = 256, BK = 64, HALF = 128, HTB = HALF * BK * 2  , STAGE_BYTES = 8 * HTB, NXCD = 8, WGM = 8;

__host__ __device__ __forceinline__ int lds_byte(int r, int c) { const int st = (r >> 4) * 2 + (c >> 5), rr = r & 15, cc = c & 31, ob = rr * 64 + cc * 2; return st * 1024 + (ob ^ (((ob >> 9) & 1) << 5)); }
__host__ __device__ __forceinline__ void stage_rc(int b, int& R, int& C) { const int st = b / 1024, sb = b % 1024, swz = sb ^ (((sb >> 9) & 1) << 5); R = (st >> 1) * 16 + swz / 64; C = (st & 1) * 32 + (swz % 64) / 2; }
__host__ __device__ __forceinline__ int perm32(int rho) { const int n = rho >> 4, i = rho & 15; return 8 * (i >> 2) + 4 * n + (i & 3); }

struct Unit { int pm, pn; };
struct Gemm { const bf16_t* A; const bf16_t* A1; int pm_split; int lda; const bf16_t* Bt; int M, N, K; int ldb = 0; int koff_pn = 1 << 30; int koff = 0; int K2 = 0; };

struct StaticOrder {
    int nM, nN, nwg, G, c;
    __host__ __device__ void init(int M, int N, int G_, int c_) { nM = M / BM; nN = N / BM; nwg = nM * nN; G = G_; c = c_; }
    __host__ __device__ bool next(int i, Unit& u) const {
        const long L = (long)i * G + c; if (L >= nwg) return false;
        int wgid = (int)L; { const int q = nwg / NXCD, r = nwg % NXCD, xcd = wgid % NXCD, off = wgid / NXCD; wgid = (xcd < r ? xcd * (q + 1) : r * (q + 1) + (xcd - r) * q) + off; }
        const int nig = WGM * nN, gid = wgid / nig, fm = gid * WGM, gsz = (nM - fm) < WGM ? (nM - fm) : WGM;
        u.pm = fm + ((wgid % nig) % gsz); u.pn = (wgid % nig) / gsz; return true;
    }
    __device__ __forceinline__ void a_ready(const Unit&) const {}
    __device__ __forceinline__ void done(const Unit&) const {}
};

__device__ __forceinline__ unsigned cvt_pk_bf16(float lo, float hi) { unsigned r; asm volatile("v_cvt_pk_bf16_f32 %0, %1, %2" : "=v"(r) : "v"(lo), "v"(hi)); return r; }
typedef float f32x2 __attribute__((ext_vector_type(2)));
__device__ __forceinline__ float sigmoidf_fast(float x) { return __builtin_amdgcn_rcpf(1.0f + __builtin_amdgcn_exp2f(-1.4426950408889634f * x)); }
__device__ __forceinline__ u32x4 pack8(const f32x4 v0, const f32x4 v1) { u32x4 w; w.x = cvt_pk_bf16(v0[0], v0[1]); w.y = cvt_pk_bf16(v0[2], v0[3]); w.z = cvt_pk_bf16(v1[0], v1[1]); w.w = cvt_pk_bf16(v1[2], v1[3]); return w; }

struct EpiStore {
    static constexpr bool PERM = true, AFTER_DRAIN = false, ROWPERM = false;
    bf16_t* O; int ldc;
    __device__ __forceinline__ void operator()(const f32x4 (&acc)[2][2][4][2], const Unit& u, int wr, int wc, int fr, int fq) const {
        const int row0 = u.pm * BM + wr * 64 + fr, col0 = u.pn * BM + wc * 32 + 8 * fq;
#pragma unroll
        for (int ai = 0; ai < 2; ++ai)
#pragma unroll
            for (int m = 0; m < 4; ++m) { bf16_t* rowp = O + (size_t)(row0 + ai * HALF + m * 16) * ldc + col0;
#pragma unroll
                for (int bj = 0; bj < 2; ++bj) *(u32x4*)(rowp + bj * HALF) = pack8(acc[ai][bj][m][0], acc[ai][bj][m][1]); }
    }
};
struct EpiStoreQK {
    static constexpr bool PERM = true, AFTER_DRAIN = false, ROWPERM = false;
    bf16_t* O; int ldc; const float* qg; const float* kg; float qscale;
    __device__ __forceinline__ void operator()(const f32x4 (&acc)[2][2][4][2], const Unit& u, int wr, int wc, int fr, int fq) const {
        const int row0 = u.pm * BM + wr * 64 + fr;
        const bool isk = u.pn < 4, isq = u.pn >= 8 && u.pn < 12;
        if (!(isk || isq)) {
            const int col0 = u.pn * BM + wc * 32 + 8 * fq;
#pragma unroll
            for (int ai = 0; ai < 2; ++ai)
#pragma unroll
                for (int m = 0; m < 4; ++m) { bf16_t* rowp = O + (size_t)(row0 + ai * HALF + m * 16) * ldc + col0;
#pragma unroll
                    for (int bj = 0; bj < 2; ++bj) *(u32x4*)(rowp + bj * HALF) = pack8(acc[ai][bj][m][0], acc[ai][bj][m][1]); }
            return;
        }
        const float* gp = isq ? qg : kg; const float sc = isq ? qscale : 1.0f;
        f32x4 gv[2][2];
#pragma unroll
        for (int bj = 0; bj < 2; ++bj)
#pragma unroll
            for (int n = 0; n < 2; ++n) gv[bj][n] = *(const f32x4*)(gp + 32 * bj + 8 * fq + 4 * n) * sc;
        const int col0 = u.pn * BM + 64 * wc + 8 * fq;
#pragma unroll
        for (int ai = 0; ai < 2; ++ai)
#pragma unroll
            for (int m = 0; m < 4; ++m) { float ss = 0.f;
#pragma unroll
                for (int bj = 0; bj < 2; ++bj)
#pragma unroll
                    for (int n = 0; n < 2; ++n) { const f32x4 v = acc[ai][bj][m][n]; ss += (v[0] * v[0] + v[1] * v[1]) + (v[2] * v[2] + v[3] * v[3]); }
                ss += __shfl_xor(ss, 16); ss += __shfl_xor(ss, 32);
                const float rs = __builtin_amdgcn_rsqf(ss * (1.0f / 64.0f) + 1e-6f);
                bf16_t* rowp = O + (size_t)(row0 + ai * HALF + m * 16) * ldc + col0;
#pragma unroll
                for (int bj = 0; bj < 2; ++bj) *(u32x4*)(rowp + 32 * bj) = pack8(acc[ai][bj][m][0] * rs * gv[bj][0], acc[ai][bj][m][1] * rs * gv[bj][1]); }
    }
};
struct EpiLora2 {
    static constexpr bool PERM = true, AFTER_DRAIN = false, ROWPERM = false;
    bf16_t* O; const float* w0; const float* a0;
    __device__ __forceinline__ void operator()(const f32x4 (&acc)[2][2][4][2], const Unit& u, int wr, int wc, int fr, int fq) const {
        const int row0 = u.pm * BM + wr * 64 + fr, col0 = u.pn * BM + wc * 32 + 8 * fq, kind = u.pn >> 2, cl = col0 & 1023;
        f32x4 bv[2][2];
#pragma unroll
        for (int bj = 0; bj < 2; ++bj)
#pragma unroll
            for (int n = 0; n < 2; ++n) bv[bj][n] = kind == 0 ? *(const f32x4*)(w0 + cl + bj * HALF + 4 * n) : kind == 1 ? *(const f32x4*)(a0 + cl + bj * HALF + 4 * n) : (f32x4){0.f, 0.f, 0.f, 0.f};
#pragma unroll
        for (int ai = 0; ai < 2; ++ai)
#pragma unroll
            for (int m = 0; m < 4; ++m) { bf16_t* rowp = O + (size_t)(row0 + ai * HALF + m * 16) * 3072 + col0;
#pragma unroll
                for (int bj = 0; bj < 2; ++bj) { f32x4 v0 = acc[ai][bj][m][0] + bv[bj][0], v1 = acc[ai][bj][m][1] + bv[bj][1];
                    if (kind < 2) { const float sc = kind == 0 ? -0.6065306597126334f : 1.0f;
#pragma unroll
                        for (int e = 0; e < 4; ++e) { v0[e] = sc * sigmoidf_fast(v0[e]); v1[e] = sc * sigmoidf_fast(v1[e]); } }
                    *(u32x4*)(rowp + bj * HALF) = pack8(v0, v1); } }
    }
};
struct EpiUp {
    static constexpr bool PERM = true, AFTER_DRAIN = false, ROWPERM = false;
    bf16_t* O; int ldc; const float* rowss; const float* biasf;
    __device__ __forceinline__ void operator()(const f32x4 (&acc)[2][2][4][2], const Unit& u, int wr, int wc, int fr, int fq) const {
        const int row0 = u.pm * BM + wr * 64 + fr, col0 = u.pn * BM + wc * 32 + 8 * fq, b = u.pm >> 4;
        f32x4 bv[2][2];
#pragma unroll
        for (int bj = 0; bj < 2; ++bj)
#pragma unroll
            for (int n = 0; n < 2; ++n) bv[bj][n] = *(const f32x4*)(biasf + (size_t)b * ldc + col0 + bj * HALF + 4 * n);
#pragma unroll
        for (int ai = 0; ai < 2; ++ai)
#pragma unroll
            for (int m = 0; m < 4; ++m) { const int row = row0 + ai * HALF + m * 16; const float rs = __builtin_amdgcn_rsqf(rowss[row] * (1.0f / 2048.0f) + 1e-6f);
                bf16_t* rowp = O + (size_t)row * ldc + col0;
#pragma unroll
                for (int bj = 0; bj < 2; ++bj) *(u32x4*)(rowp + bj * HALF) = pack8(acc[ai][bj][m][0] * rs + bv[bj][0], acc[ai][bj][m][1] * rs + bv[bj][1]); }
    }
};
struct EpiOut {
    static constexpr bool PERM = true, AFTER_DRAIN = false, ROWPERM = false;
    const float* x; bf16_t* x1b; bf16_t* XG; float* rowss; const float* gate; const float* gs;
    int gstride;
    __device__ __forceinline__ void operator()(const f32x4 (&acc)[2][2][4][2], const Unit& u, int wr, int wc, int fr, int fq) const {
        const int row0 = u.pm * BM + wr * 64 + fr, col0 = u.pn * BM + wc * 64 + 8 * fq, b = u.pm >> 4;
        f32x4 gv[2][2], sv[2][2];
#pragma unroll
        for (int bj = 0; bj < 2; ++bj)
#pragma unroll
            for (int n = 0; n < 2; ++n) { gv[bj][n] = *(const f32x4*)(gate + (size_t)b * gstride + col0 + bj * 32 + n * 4); sv[bj][n] = *(const f32x4*)(gs + (size_t)b * 2048 + col0 + bj * 32 + n * 4); }
        f32x4 xa[4], xb[4], xc[4], xd[4], xe[4];
#define EPO_LOAD(G, XV) { const int ai_ = (G) >> 2, m_ = (G) & 3; const size_t off_ = (size_t)(row0 + ai_ * HALF + m_ * 16) * 2048 + col0; \
            _Pragma("unroll") for (int bj_ = 0; bj_ < 2; ++bj_) _Pragma("unroll") for (int n_ = 0; n_ < 2; ++n_) XV[bj_ * 2 + n_] = *(const f32x4*)(x + off_ + bj_ * 32 + n_ * 4); }
#define EPO_DO(G, XV) { const int ai = (G) >> 2, m = (G) & 3; const int row = row0 + ai * HALF + m * 16; const size_t off = (size_t)row * 2048 + col0; float ss = 0.f; \
            _Pragma("unroll") for (int bj = 0; bj < 2; ++bj) { const f32x4 xl = XV[bj * 2] + gv[bj][0] * acc[ai][bj][m][0], xh = XV[bj * 2 + 1] + gv[bj][1] * acc[ai][bj][m][1]; \
                *(u32x4*)(x1b + off + bj * 32) = pack8(xl, xh); ss += ((xl[0] * xl[0] + xl[1] * xl[1]) + (xl[2] * xl[2] + xl[3] * xl[3])) + ((xh[0] * xh[0] + xh[1] * xh[1]) + (xh[2] * xh[2] + xh[3] * xh[3])); \
                *(u32x4*)(XG + off + bj * 32) = pack8(xl * sv[bj][0], xh * sv[bj][1]); } \
            ss += __shfl_xor(ss, 16); ss += __shfl_xor(ss, 32); if (fq == 0) atomicAdd(rowss + row, ss); }
        EPO_LOAD(0, xa); EPO_LOAD(1, xb); EPO_LOAD(2, xc); EPO_DO(0, xa); EPO_DO(1, xb); EPO_DO(2, xc); EPO_LOAD(3, xa); EPO_LOAD(4, xb); EPO_LOAD(5, xc); EPO_LOAD(6, xd); EPO_LOAD(7, xe); EPO_DO(3, xa); EPO_DO(4, xb); EPO_DO(5, xc); EPO_DO(6, xd); EPO_DO(7, xe);
#undef EPO_LOAD
#undef EPO_DO
    }
};
struct EpiDown {
    static constexpr bool PERM = true, AFTER_DRAIN = false, ROWPERM = false;
    float* out; const bf16_t* x1b; const float* gate; int gstride;
    __device__ __forceinline__ void operator()(const f32x4 (&acc)[2][2][4][2], const Unit& u, int wr, int wc, int fr, int fq) const {
        const int row0 = u.pm * BM + wr * 64 + fr, col0 = u.pn * BM + wc * 64 + 8 * fq, b = u.pm >> 4;
        f32x4 gv[2][2];
#pragma unroll
        for (int bj = 0; bj < 2; ++bj)
#pragma unroll
            for (int n = 0; n < 2; ++n) gv[bj][n] = *(const f32x4*)(gate + (size_t)b * gstride + col0 + bj * 32 + n * 4);
        u32x4 xa[2], xb[2], xc[2], xd[2], xe[2], xf[2], xg[2], xh[2];
#define EPD_LOAD(G, XV) { const int ai_ = (G) >> 2, m_ = (G) & 3; const size_t off_ = (size_t)(row0 + ai_ * HALF + m_ * 16) * 2048 + col0; \
            _Pragma("unroll") for (int bj_ = 0; bj_ < 2; ++bj_) XV[bj_] = *(const u32x4*)(x1b + off_ + bj_ * 32); }
#define EPD_DO(G, XV) { const int ai = (G) >> 2, m = (G) & 3; const size_t off = (size_t)(row0 + ai * HALF + m * 16) * 2048 + col0; \
            _Pragma("unroll") for (int bj = 0; bj < 2; ++bj) { const u32x4 w_ = XV[bj]; \
                const f32x4 xl_ = {__uint_as_float(w_.x << 16), __uint_as_float(w_.x & 0xffff0000u), __uint_as_float(w_.y << 16), __uint_as_float(w_.y & 0xffff0000u)}; \
                const f32x4 xh_ = {__uint_as_float(w_.z << 16), __uint_as_float(w_.z & 0xffff0000u), __uint_as_float(w_.w << 16), __uint_as_float(w_.w & 0xffff0000u)}; \
                *(f32x4*)(out + off + bj * 32) = xl_ + gv[bj][0] * acc[ai][bj][m][0]; *(f32x4*)(out + off + bj * 32 + 4) = xh_ + gv[bj][1] * acc[ai][bj][m][1]; } }
        EPD_LOAD(0, xa); EPD_LOAD(1, xb); EPD_LOAD(2, xc); EPD_LOAD(3, xd); EPD_LOAD(4, xe); EPD_LOAD(5, xf); EPD_LOAD(6, xg); EPD_LOAD(7, xh); EPD_DO(0, xa); EPD_DO(1, xb); EPD_DO(2, xc); EPD_DO(3, xd); EPD_DO(4, xe); EPD_DO(5, xf); EPD_DO(6, xg); EPD_DO(7, xh);
#undef EPD_LOAD
#undef EPD_DO
    }
};

struct EpiUpGlu {
    static constexpr bool PERM = true, AFTER_DRAIN = false, ROWPERM = true;
    bf16_t* ACT; const float* rowss; const float* biasf; const float* cw; const float* cb; float* uph; float* halo;
    static __device__ __forceinline__ float shr1(float x) { return __int_as_float(__builtin_amdgcn_update_dpp(0, __float_as_int(x), 0x111, 0xF, 0xF, true)); }
    __device__ __forceinline__ void operator()(const f32x4 (&acc)[2][2][4][2], const Unit& u, int wr, int wc, int fr, int fq) const {
        const int T0 = u.pm * BM + 8 * (16 * wr + fr), b = u.pm >> 4, jb = 128 * u.pn + 32 * wc + 8 * fq, blk = 2 * u.pm + wr;
        float rs[8];
#pragma unroll
        for (int k = 0; k < 8; ++k) rs[k] = __builtin_amdgcn_rsqf(rowss[T0 + k] * (1.0f / 2048.0f) + 1e-6f);
        unsigned pkd[8][4];
#pragma unroll
        for (int n = 0; n < 2; ++n) { const int cg = jb + 4 * n, cv = 5632 + cg;
            const f32x4 bg = *(const f32x4*)(biasf + (size_t)b * 11264 + cg), bv = *(const f32x4*)(biasf + (size_t)b * 11264 + cv), cbg = *(const f32x4*)(cb + cg), cbv = *(const f32x4*)(cb + cv);
            const f32x4 g0 = *(const f32x4*)(cw + cg), g1 = *(const f32x4*)(cw + 11264 + cg), g2 = *(const f32x4*)(cw + 22528 + cg), v0 = *(const f32x4*)(cw + cv), v1 = *(const f32x4*)(cw + 11264 + cv), v2 = *(const f32x4*)(cw + 22528 + cv);
            float a8[8][4];
            typedef float f2_ __attribute__((ext_vector_type(2)));
#pragma unroll
            for (int ep = 0; ep < 2; ++ep) { f2_ ug[8], uv[8];
                const f2_ bg2 = {bg[2 * ep], bg[2 * ep + 1]}, bv2 = {bv[2 * ep], bv[2 * ep + 1]}, cbg2 = {cbg[2 * ep], cbg[2 * ep + 1]}, cbv2 = {cbv[2 * ep], cbv[2 * ep + 1]};
                const f2_ g02 = {g0[2 * ep], g0[2 * ep + 1]}, g12 = {g1[2 * ep], g1[2 * ep + 1]}, g22 = {g2[2 * ep], g2[2 * ep + 1]}, v02 = {v0[2 * ep], v0[2 * ep + 1]}, v12 = {v1[2 * ep], v1[2 * ep + 1]}, v22 = {v2[2 * ep], v2[2 * ep + 1]};
#pragma unroll
                for (int k = 0; k < 8; ++k) { const f32x4 ag = acc[k >> 2][0][k & 3][n], av = acc[k >> 2][1][k & 3][n]; const f2_ ag2 = {ag[2 * ep], ag[2 * ep + 1]}, av2 = {av[2 * ep], av[2 * ep + 1]};
                    ug[k] = ag2 * rs[k] + bg2; uv[k] = av2 * rs[k] + bv2; }
                const f2_ hg1 = {shr1(ug[7][0]), shr1(ug[7][1])}, hg2 = {shr1(ug[6][0]), shr1(ug[6][1])}, hv1 = {shr1(uv[7][0]), shr1(uv[7][1])}, hv2 = {shr1(uv[6][0]), shr1(uv[6][1])};
                if (fr == 0) { float* p = uph + (size_t)(blk * 2) * 11264 + 2 * ep; *(f2_*)(p + cg) = ug[0]; *(f2_*)(p + 11264 + cg) = ug[1]; *(f2_*)(p + cv) = uv[0]; *(f2_*)(p + 11264 + cv) = uv[1]; }
                if (fr == 15) { float* p = halo + (size_t)(blk * 2) * 11264 + 2 * ep; *(f2_*)(p + cg) = ug[6]; *(f2_*)(p + 11264 + cg) = ug[7]; *(f2_*)(p + cv) = uv[6]; *(f2_*)(p + 11264 + cv) = uv[7]; }
#pragma unroll
                for (int k = 0; k < 8; ++k) { const f2_ pg1 = k >= 1 ? ug[k - 1] : hg1, pg2 = k >= 2 ? ug[k - 2] : (k == 1 ? hg1 : hg2), pv1 = k >= 1 ? uv[k - 1] : hv1, pv2 = k >= 2 ? uv[k - 2] : (k == 1 ? hv1 : hv2);
                    const f2_ yg = cbg2 + g02 * pg2 + g12 * pg1 + g22 * ug[k], yv = cbv2 + v02 * pv2 + v12 * pv1 + v22 * uv[k];
                    const f2_ sg = {sigmoidf_fast(yg[0]), sigmoidf_fast(yg[1])}; const f2_ a2 = yg * sg * yv;
                    a8[k][2 * ep] = a2[0]; a8[k][2 * ep + 1] = a2[1]; } }
#pragma unroll
            for (int k = 0; k < 8; ++k) { pkd[k][2 * n] = cvt_pk_bf16(a8[k][0], a8[k][1]); pkd[k][2 * n + 1] = cvt_pk_bf16(a8[k][2], a8[k][3]); } }
#pragma unroll
        for (int k = 0; k < 8; ++k) if (!(fr == 0 && k < 2)) *(u32x4*)(ACT + (size_t)(T0 + k) * 5632 + jb) = (u32x4){pkd[k][0], pkd[k][1], pkd[k][2], pkd[k][3]};
    }
};

template <class Epi, class Sched, bool ALIGN_EPI = false, bool SP2 = false>
__device__ __forceinline__ void gemm_phase(PG8_LAS unsigned char* lds, const Gemm g, const Sched& S, const Epi& E, const int wid) {
    const int lane = mk_lane_id(), tid = wid * 64 + lane, wr = wid >> 2, wc = wid & 3, fr = lane & 15, fq = lane >> 4;
    const int K = g.K, nt = K / BK, nt2 = g.K2 ? g.K2 / BK : nt, lda = g.lda, ldb = g.ldb ? g.ldb : K;
#define PG8_KOFS(pn) ((pn) >= g.koff_pn ? (size_t)g.koff * 2 : (size_t)0)
    unsigned voffA[2], voffB[2];
#pragma unroll
    for (int i = 0; i < 2; ++i) { int R, C; stage_rc(tid * 16 + i * 8192, R, C); const int Rb = Epi::PERM ? ((R & ~31) + perm32(R & 31)) : R;
        const int Ra = Epi::ROWPERM ? (8 * (16 * (R >> 6) + (R & 15)) + ((R >> 4) & 3)) : R;
        voffA[i] = (unsigned)(Ra * lda + C) * 2u; voffB[i] = (unsigned)(Rb * ldb + C) * 2u; }
    const size_t kstep = (size_t)(BK * 2);
    const size_t hstepA = Epi::ROWPERM ? (size_t)4 * lda * 2 : (size_t)HALF * lda * 2, hstepB = (size_t)HALF * ldb * 2;
    const size_t tstepA = (size_t)BM * lda * 2, tstepB = 2 * hstepB;
#define PG8_ABASE(pm) ((pm) < g.pm_split ? (const char*)g.A + (size_t)(pm) * tstepA : (const char*)g.A1 + (size_t)((pm) - g.pm_split) * tstepA)
    const unsigned ldsw = (unsigned)wid * 1024u;
    const int aoff = lds_byte(wr * 64 + fr, fq * 8), boff = lds_byte(wc * 32 + fr, fq * 8);
#define PG8_SA(b, h) (((b) * 2 + (h)) * HTB)
#define PG8_SB(b, h) ((4 + (b) * 2 + (h)) * HTB)
#define PG8_STAGE(bufoff, gbase, voff) do { _Pragma("unroll") for (int _i = 0; _i < 2; ++_i) \
        __builtin_amdgcn_global_load_lds((const unsigned*)((const char*)(gbase) + (voff)[_i]), (PG8_LAS unsigned*)(lds + (bufoff) + ldsw + _i * 8192), 16, 0, 0); } while (0)
#define PG8_LDA(dst, b, h) do { _Pragma("unroll") for (int m = 0; m < 4; ++m) _Pragma("unroll") for (int k = 0; k < 2; ++k) dst[m][k] = *(const PG8_LAS bf16x8*)(lds + PG8_SA(b, h) + aoff + m * 2048 + k * 1024); } while (0)
#define PG8_LDB(dst, b, h) do { _Pragma("unroll") for (int n = 0; n < 2; ++n) _Pragma("unroll") for (int k = 0; k < 2; ++k) dst[n][k] = *(const PG8_LAS bf16x8*)(lds + PG8_SB(b, h) + boff + n * 2048 + k * 1024); } while (0)
#define PG8_MMA(ai, bj, At, Bt) do { __builtin_amdgcn_s_setprio(1); _Pragma("unroll") for (int m = 0; m < 4; ++m) _Pragma("unroll") for (int n = 0; n < 2; ++n) _Pragma("unroll") for (int k = 0; k < 2; ++k) \
        acc[ai][bj][m][n] = __builtin_amdgcn_mfma_f32_16x16x32_bf16(Bt[n][k], At[m][k], acc[ai][bj][m][n], 0, 0, 0); __builtin_amdgcn_s_setprio(0); } while (0)
#define PG8_WAIT_V(n) asm volatile("s_waitcnt vmcnt(" #n ")" ::: "memory")
#define PG8_WAIT_L(n) asm volatile("s_waitcnt lgkmcnt(" #n ")" ::: "memory")
#define PG8_BAR __builtin_amdgcn_s_barrier()
#define PG8_SCHED __builtin_amdgcn_sched_barrier(0)
    Unit cur, nxt; int ui = 0;
    if (!S.next(0, cur)) return;
    f32x4 acc[2][2][4][2];
#pragma unroll
    for (int a = 0; a < 2; ++a)
#pragma unroll
        for (int b = 0; b < 2; ++b)
#pragma unroll
            for (int m = 0; m < 4; ++m)
#pragma unroll
                for (int n = 0; n < 2; ++n) acc[a][b][m][n] = (f32x4){0.f, 0.f, 0.f, 0.f};
    bf16x8 At[4][2], B0[2][2], B1[2][2];
    const char* cA = PG8_ABASE(cur.pm) + PG8_KOFS(cur.pn); const char* cB = (const char*)g.Bt + (size_t)cur.pn * tstepB + PG8_KOFS(cur.pn);
    S.a_ready(cur);
    if constexpr (SP2) {
        PG8_STAGE(PG8_SB(0, 0), cB, voffB); PG8_STAGE(PG8_SB(0, 1), cB + hstepB, voffB); PG8_STAGE(PG8_SA(0, 0), cA, voffA); PG8_STAGE(PG8_SA(0, 1), cA + hstepA, voffA);
        if (wr == 1) PG8_BAR;
        PG8_WAIT_V(2); PG8_BAR;
        PG8_STAGE(PG8_SB(1, 0), cB + kstep, voffB); PG8_STAGE(PG8_SA(1, 0), cA + kstep, voffA); PG8_STAGE(PG8_SB(1, 1), cB + hstepB + kstep, voffB);
        PG8_WAIT_V(6); PG8_BAR;
    } else {
        PG8_STAGE(PG8_SB(0, 0), cB, voffB); PG8_STAGE(PG8_SA(0, 0), cA, voffA); PG8_STAGE(PG8_SB(0, 1), cB + hstepB, voffB); PG8_STAGE(PG8_SA(0, 1), cA + hstepA, voffA);
        if (wr == 1) PG8_BAR;
        PG8_WAIT_V(4); PG8_BAR;
        PG8_STAGE(PG8_SB(1, 0), cB + kstep, voffB); PG8_STAGE(PG8_SA(1, 0), cA + kstep, voffA); PG8_STAGE(PG8_SB(1, 1), cB + hstepB + kstep, voffB);
        PG8_WAIT_V(6); PG8_BAR;
    }
    for (;;) {
        const bool has_next = S.next(ui + 1, nxt);
        const char* nA = has_next ? PG8_ABASE(nxt.pm) + PG8_KOFS(nxt.pn) : cA; const char* nB = has_next ? (const char*)g.Bt + (size_t)nxt.pn * tstepB + PG8_KOFS(nxt.pn) : cB;
        const int ntu = (cur.pn >= g.koff_pn) ? nt : nt2;
        for (int t = 0; t < ntu; t += 2) {
            const bool last = (t == ntu - 2);
            const char* a1 = cA + (size_t)(t + 1) * kstep;
            const char* a2 = last ? nA : cA + (size_t)(t + 2) * kstep; const char* b2 = last ? nB : cB + (size_t)(t + 2) * kstep;
            const char* a3 = a2 + kstep; const char* b3 = b2 + kstep;
            if (last && has_next) S.a_ready(nxt);
            if constexpr (SP2) {
            PG8_LDB(B0, 0, 0); PG8_LDB(B1, 0, 1); PG8_SCHED; PG8_LDA(At, 0, 0); PG8_STAGE(PG8_SA(1, 1), a1 + hstepA, voffA);
            PG8_WAIT_V(8); PG8_WAIT_L(0); PG8_BAR; PG8_MMA(0, 0, At, B0); PG8_MMA(0, 1, At, B1); PG8_BAR; PG8_SCHED;
            PG8_LDA(At, 0, 1); PG8_STAGE(PG8_SB(0, 0), b2, voffB); PG8_STAGE(PG8_SB(0, 1), b2 + hstepB, voffB); PG8_STAGE(PG8_SA(0, 0), a2, voffA);
            PG8_WAIT_V(8); PG8_WAIT_L(0); PG8_BAR; PG8_MMA(1, 0, At, B0); PG8_MMA(1, 1, At, B1); PG8_BAR; PG8_SCHED;
            PG8_LDB(B0, 1, 0); PG8_LDB(B1, 1, 1); PG8_SCHED; PG8_LDA(At, 1, 0); PG8_STAGE(PG8_SA(0, 1), a2 + hstepA, voffA);
            PG8_WAIT_V(8); PG8_WAIT_L(0); PG8_BAR; PG8_MMA(0, 0, At, B0); PG8_MMA(0, 1, At, B1); PG8_BAR; PG8_SCHED;
            PG8_LDA(At, 1, 1); PG8_STAGE(PG8_SB(1, 0), b3, voffB); PG8_STAGE(PG8_SB(1, 1), b3 + hstepB, voffB); PG8_STAGE(PG8_SA(1, 0), a3, voffA);
            PG8_WAIT_V(8); PG8_WAIT_L(0); PG8_BAR; PG8_MMA(1, 0, At, B0); PG8_MMA(1, 1, At, B1); PG8_BAR; PG8_SCHED;
            } else {
            PG8_LDB(B0, 0, 0); PG8_SCHED; PG8_LDA(At, 0, 0); PG8_STAGE(PG8_SA(1, 1), a1 + hstepA, voffA);
            PG8_WAIT_L(8); PG8_BAR; PG8_WAIT_L(0); PG8_MMA(0, 0, At, B0); PG8_BAR; PG8_SCHED;
            PG8_LDB(B1, 0, 1); PG8_STAGE(PG8_SB(0, 0), b2, voffB);
            PG8_BAR; PG8_WAIT_L(0); PG8_MMA(0, 1, At, B1); PG8_BAR;
            PG8_LDA(At, 0, 1); PG8_STAGE(PG8_SA(0, 0), a2, voffA);
            PG8_BAR; PG8_WAIT_L(0); PG8_MMA(1, 0, At, B0); PG8_BAR; PG8_SCHED;
            PG8_STAGE(PG8_SB(0, 1), b2 + hstepB, voffB);
            PG8_WAIT_V(6); PG8_BAR; PG8_MMA(1, 1, At, B1); PG8_BAR;
            PG8_LDB(B0, 1, 0); PG8_SCHED; PG8_LDA(At, 1, 0); PG8_STAGE(PG8_SA(0, 1), a2 + hstepA, voffA);
            PG8_WAIT_L(8); PG8_BAR; PG8_WAIT_L(0); PG8_MMA(0, 0, At, B0); PG8_BAR; PG8_SCHED;
            PG8_LDB(B1, 1, 1); PG8_STAGE(PG8_SB(1, 0), b3, voffB);
            PG8_BAR; PG8_WAIT_L(0); PG8_MMA(0, 1, At, B1); PG8_BAR;
            PG8_LDA(At, 1, 1); PG8_STAGE(PG8_SA(1, 0), a3, voffA);
            PG8_BAR; PG8_WAIT_L(0); PG8_MMA(1, 0, At, B0); PG8_BAR; PG8_SCHED;
            PG8_STAGE(PG8_SB(1, 1), b3 + hstepB, voffB);
            PG8_WAIT_V(6); PG8_BAR; PG8_MMA(1, 1, At, B1); PG8_BAR;
            }
        }
        if constexpr (ALIGN_EPI) { if (wr == 0) PG8_BAR; }
        if constexpr (!Epi::AFTER_DRAIN) { E(acc, cur, wr, wc, fr, fq); S.done(cur); }
        if (!has_next) break;
#pragma unroll
        for (int a = 0; a < 2; ++a)
#pragma unroll
            for (int b = 0; b < 2; ++b)
#pragma unroll
                for (int m = 0; m < 4; ++m)
#pragma unroll
                    for (int n = 0; n < 2; ++n) acc[a][b][m][n] = (f32x4){0.f, 0.f, 0.f, 0.f};
        cur = nxt; cA = nA; cB = nB; ++ui;
        if constexpr (ALIGN_EPI) { if (wr == 1) PG8_BAR; }
    }
    PG8_WAIT_V(0);
    if constexpr (!ALIGN_EPI) { if (wr == 0) PG8_BAR; }
    PG8_BAR;
    if constexpr (Epi::AFTER_DRAIN) { E.fused(acc, cur, wr, wc, fr, fq, lds, wid, lane); S.done(cur); }
#undef PG8_ABASE
#undef PG8_KOFS
#undef PG8_SA
#undef PG8_SB
#undef PG8_STAGE
#undef PG8_LDA
#undef PG8_LDB
#undef PG8_MMA
#undef PG8_WAIT_V
#undef PG8_WAIT_L
#undef PG8_BAR
#undef PG8_SCHED
}
}

#include <hip/hip_bf16.h>
#include <cmath>
namespace attn_body {
using bf16=__hip_bfloat16;
using bf16x8=__attribute__((ext_vector_type(8)))short;
using s16x4=__attribute__((ext_vector_type(4)))short;
using f32x16=__attribute__((ext_vector_type(16)))float;
using u32x4=__attribute__((ext_vector_type(4)))unsigned;
constexpr int BATCH=4,SEQ=4096,D=64,DM=6912,OPITCH=2048;
constexpr int NW=8,QBLK=32,QB=QBLK*NW,KVBLK=64,NQB=SEQ/QB;
constexpr int ATTN_PITCH=DM, ATTN_UNIT_ROWS=QB;
__device__ __forceinline__ int crow(int r,int hi){return (r&3)+8*(r>>2)+4*hi;}
#define SBAR() __builtin_amdgcn_sched_barrier(0)
typedef __attribute__((address_space(3))) const float* lds_cfptr;
__device__ __forceinline__ void bias_add(f32x16&p0,f32x16&p1,lds_cfptr tabr,int cb){
  #pragma unroll
  for(int r=0;r<16;++r){const int k=(r&3)+8*(r>>2); p0[r]+=tabr[cb+k]; p1[r]+=tabr[cb+k+32];}
}
constexpr int LDS_TAB=110592, TAB_N=640;
constexpr int NSLOT=3, SLOTB=8192;
constexpr int LDS_K=0, LDS_V=NSLOT*SLOTB, LDS_WS=3*NSLOT*SLOTB, LDS_OST=LDS_WS+NW*64*4, LDS_BYTES=LDS_OST+NW*4096;
constexpr float C2=0.125f*1.4426950408889634f;
__device__ __forceinline__ void glds16(const void*gsrc,unsigned lds_dst){unsigned keep;
  asm volatile("s_mov_b32 %0, m0\n\ts_mov_b32 m0, %2\n\ts_nop 0\n\tglobal_load_lds_dwordx4 %1, off\n\ts_mov_b32 m0, %0":"=&s"(keep):"v"(gsrc),"s"(lds_dst):"memory");}
__device__ __forceinline__ float max3f(float a,float b,float c){float r;asm("v_max3_f32 %0, %1, %2, %3":"=v"(r):"v"(a),"v"(b),"v"(c));return r;}
__device__ __forceinline__ float max2f(float a,float b){float r;asm("v_max_f32_e32 %0, %1, %2":"=v"(r):"v"(a),"v"(b));return r;}
__device__ __forceinline__ float fadd_s(float a,float b){float r;asm("v_add_f32_e32 %0, %1, %2":"=v"(r):"v"(a),"v"(b));return r;}
__device__ __forceinline__ float fsub_s(float a,float b){float r;asm("v_sub_f32_e32 %0, %1, %2":"=v"(r):"v"(a),"v"(b));return r;}
typedef float f32x2_t __attribute__((ext_vector_type(2))); typedef __bf16 bf16x2_t __attribute__((ext_vector_type(2)));
__device__ __forceinline__ unsigned cvtpk_s(float lo,float hi){f32x2_t v={lo,hi};bf16x2_t b=__builtin_convertvector(v,bf16x2_t);return __builtin_bit_cast(unsigned,b);}
#define WAIT_BAR(N) asm volatile("s_waitcnt vmcnt(" #N ") lgkmcnt(0)\n\ts_barrier":::"memory")

__device__ __forceinline__ void qkt(f32x16&p0,f32x16&p1,const char*Kslot,const bf16x8*qr,const f32x16&negm,int r32,int hi){
  const char*kb=Kslot+hi*1024+r32*16;
  #pragma unroll
  for(int d0=0;d0<4;++d0){
    const bf16x8 b0=*reinterpret_cast<const bf16x8*>(kb+d0*2048);
    const bf16x8 b1=*reinterpret_cast<const bf16x8*>(kb+d0*2048+512);
    if(d0==0){p0=__builtin_amdgcn_mfma_f32_32x32x16_bf16(b0,qr[0],negm,0,0,0);p1=__builtin_amdgcn_mfma_f32_32x32x16_bf16(b1,qr[0],negm,0,0,0);}
    else{p0=__builtin_amdgcn_mfma_f32_32x32x16_bf16(b0,qr[d0],p0,0,0,0);p1=__builtin_amdgcn_mfma_f32_32x32x16_bf16(b1,qr[d0],p1,0,0,0);}}
}
typedef __attribute__((address_space(3))) const char* lds_cptr;
typedef short v4i16_t __attribute__((ext_vector_type(4)));
__device__ __forceinline__ void kload8(bf16x8*kf,lds_cptr kp){
  kf[0]=*(const __attribute__((address_space(3))) bf16x8*)(kp);      kf[1]=*(const __attribute__((address_space(3))) bf16x8*)(kp+512);
  kf[2]=*(const __attribute__((address_space(3))) bf16x8*)(kp+2048); kf[3]=*(const __attribute__((address_space(3))) bf16x8*)(kp+2560);
  kf[4]=*(const __attribute__((address_space(3))) bf16x8*)(kp+4096); kf[5]=*(const __attribute__((address_space(3))) bf16x8*)(kp+4608);
  kf[6]=*(const __attribute__((address_space(3))) bf16x8*)(kp+6144); kf[7]=*(const __attribute__((address_space(3))) bf16x8*)(kp+6656);
}
__device__ __forceinline__ void kload2(bf16x8*kf,lds_cptr kp,int j){ kf[2*j]=*(const __attribute__((address_space(3))) bf16x8*)(kp+j*2048); kf[2*j+1]=*(const __attribute__((address_space(3))) bf16x8*)(kp+j*2048+512); }
__device__ __forceinline__ s16x4 vtr(lds_cptr p){ return __builtin_bit_cast(s16x4,__builtin_amdgcn_ds_read_tr16_b64_v4i16((__attribute__((address_space(3))) v4i16_t*)p)); }
__device__ __forceinline__ float rowmax(const f32x16&p0,const f32x16&p1){
  float a=max3f(p0[0],p0[1],p1[0]),b=max3f(p0[2],p0[3],p1[1]);a=max3f(a,p1[2],p1[3]);
  #pragma unroll
  for(int r=4;r<16;r+=4){a=max3f(a,p0[r],p0[r+1]);b=max3f(b,p0[r+2],p0[r+3]);a=max3f(a,p1[r],p1[r+1]);b=max3f(b,p1[r+2],p1[r+3]);}
  const float m=max2f(a,b);
  auto rr=__builtin_amdgcn_permlane32_swap(__float_as_uint(m),__float_as_uint(m),false,false);
  return max2f(__uint_as_float(rr[0]),__uint_as_float(rr[1]));
}
__device__ __forceinline__ void pv(f32x16*o,int vb,bf16x8 pa0,bf16x8 pa1,bf16x8 pa2,bf16x8 pa3){
  #pragma unroll
  for(int d0=0;d0<2;++d0){s16x4 lo[4],hi[4];
    #pragma unroll
    for(int ks=0;ks<4;++ks){
      asm volatile("ds_read_b64_tr_b16 %0,%1 offset:%c2":"=&v"(lo[ks]):"v"(vb),"i"(d0*4096+ks*1024):"memory");
      asm volatile("ds_read_b64_tr_b16 %0,%1 offset:%c2":"=&v"(hi[ks]):"v"(vb),"i"(d0*4096+ks*1024+512):"memory");}
    asm volatile("s_waitcnt lgkmcnt(0)":::"memory");SBAR();
    #define PK(k) (bf16x8){lo[k][0],lo[k][1],lo[k][2],lo[k][3],hi[k][0],hi[k][1],hi[k][2],hi[k][3]}
    o[d0]=__builtin_amdgcn_mfma_f32_32x32x16_bf16(pa0,PK(0),o[d0],0,0,0);
    o[d0]=__builtin_amdgcn_mfma_f32_32x32x16_bf16(pa1,PK(1),o[d0],0,0,0);
    o[d0]=__builtin_amdgcn_mfma_f32_32x32x16_bf16(pa2,PK(2),o[d0],0,0,0);
    o[d0]=__builtin_amdgcn_mfma_f32_32x32x16_bf16(pa3,PK(3),o[d0],0,0,0);
    #undef PK
  }
}

#ifndef ATTN_STORE16
#define ATTN_STORE16(p,v) (*(u32x4*)(p)=(v))
#endif
template<int THRL> __device__ __forceinline__ void attn_unit(int b,int qcol,int kcol,int vcol,int ocol,int qb,const bf16*__restrict__ PB,bf16*O,char*shm,const int wid,const int tab_off,unsigned*qctr,volatile __attribute__((address_space(3))) unsigned*slot,
                                                             const bool second,bf16*PQ,const int pqcol,const float*lamp,const float*subg){
  const int lane=mk_lane_id(),r32=lane&31,hi=lane>>5;
  const long rowbase=(long)b*SEQ; const int q0=qb*QB;
  const bf16*Qw=PB+(rowbase+q0+wid*QBLK)*DM+qcol;
  const bf16*Kh=PB+rowbase*DM+kcol,*Vh=PB+rowbase*DM+vcol;
  const unsigned lds0=(unsigned)(uintptr_t)shm;
  __attribute__((address_space(3))) float*wsf=(__attribute__((address_space(3))) float*)(shm+LDS_WS)+wid*64;
  const bf16*ksrc=Kh+(long)lane*DM+wid*8;
  const bf16*vsrc=Vh+(long)(16*(wid&3)+(lane>>2))*DM+(wid>>2)*32+(lane&3)*8;
  const unsigned kdst=lds0+LDS_K+wid*1024, vdst=lds0+LDS_V+wid*1024;
  #define DMA_K(t,slot) glds16(ksrc+(long)(t)*KVBLK*DM,(unsigned)__builtin_amdgcn_readfirstlane(kdst+(slot)))
  #define DMA_V(t,slot) do{ glds16(vsrc+(long)(t)*KVBLK*DM,(unsigned)__builtin_amdgcn_readfirstlane(vdst+2*(slot))); glds16(vsrc+64+(long)(t)*KVBLK*DM,(unsigned)__builtin_amdgcn_readfirstlane(vdst+2*(slot)+8192)); }while(0)
  const char*Kbase=shm+LDS_K; bf16x8 kf[8];
  const lds_cptr shm3=(lds_cptr)shm; const lds_cptr kp0=shm3+LDS_K+hi*1024+r32*16; const lds_cptr vp0=shm3+LDS_V+((lane>>4)&1)*32+(lane&3)*8+(4*hi+((lane&15)>>2))*64;
  const int NT=(q0+QB)/KVBLK;
  DMA_K(0,0);DMA_V(0,0);DMA_K(1,SLOTB);
  bf16x8 qr[4];
  #pragma unroll
  for(int d0=0;d0<4;++d0)qr[d0]=*reinterpret_cast<const bf16x8*>(&Qw[(long)r32*DM+d0*16+hi*8]);
  float mhat=0.f,l_reg=0.f;f32x16 o[4];o[0]=f32x16{};o[1]=f32x16{};o[2]=f32x16{};o[3]=f32x16{};f32x16 negm=f32x16{};asm volatile("":"+v"(negm));
  const int qrel=wid*QBLK+r32; const lds_cfptr tabr=(lds_cfptr)(shm3+LDS_TAB); const int cb0=tab_off+383-q0-qrel+4*hi;
  #define CMASK(P0,P1,t) do{ if((t)>=NT-6) bias_add(P0,P1,tabr,cb0+64*(t)); }while(0)
  bool resc=false;
  #define START(P0,P1) do{ const float rm=rowmax(P0,P1); resc=false; \
    { const float dl=rm; mhat=fadd_s(mhat,dl); \
      _Pragma("unroll") for(int r=0;r<16;++r){P0[r]=fsub_s(P0[r],dl);P1[r]=fsub_s(P1[r],dl);} \
      _Pragma("unroll") for(int r=0;r<16;++r)negm[r]=-mhat; asm volatile("":"+v"(negm)); } \
    _Pragma("unroll") for(int r=0;r<16;++r)P0[r]=__builtin_amdgcn_exp2f(P0[r]); }while(0)
  #define RESC() do{ if(resc){ asm volatile("s_waitcnt lgkmcnt(0)":::"memory"); \
      _Pragma("unroll") for(int d_=0;d_<4;++d_) _Pragma("unroll") for(int r=0;r<16;++r)o[d_][r]*=wsf[crow(r,hi)]; } }while(0)
  f32x16 pA0,pA1,pB0,pB1;
  int sl_prev=0,sl_cur=0,sl_next=SLOTB;
  #define ROT() do{sl_prev=sl_cur;sl_cur=sl_next;sl_next=(sl_next==(NSLOT-1)*SLOTB)?0:sl_next+SLOTB;}while(0)
  DMA_K(2,2*SLOTB);
  WAIT_BAR(4);
  qkt(pA0,pA1,Kbase,qr,negm,r32,hi);asm volatile("s_nop 15\n\ts_nop 7":"+v"(pA0),"+v"(pA1));CMASK(pA0,pA1,0);
  START(pA0,pA1);
  _Pragma("unroll") for(int r=0;r<16;++r)pA1[r]=__builtin_amdgcn_exp2f(pA1[r]);
  WAIT_BAR(0);
  DMA_K(3,0);DMA_V(1,SLOTB);
  ROT();
  kload8(kf,kp0+sl_cur);
  WAIT_BAR(3);
  s16x4 vlo[8],vhi[8]; u32x4 pw0,pw1,pw2,pw3;
  #define PKW(P,B) cvtpk_s(P[B],P[B+1])
  #define PAF(k) __builtin_bit_cast(bf16x8,pw##k)
  #define VFR(i) (bf16x8){vlo[i][0],vlo[i][1],vlo[i][2],vlo[i][3],vhi[i][0],vhi[i][1],vhi[i][2],vhi[i][3]}
  #define PIN(x) asm volatile("":"+v"(x))
  #define MX3(a,b,c) __builtin_fmaxf(__builtin_fmaxf((a),(b)),(c))
  #define GAPA(MF,A0,A1,A2,A3,W0,W1,PW) do{ MF; sacc+=A0; sacc+=A1; sacc+=A2; sacc+=A3; PIN(sacc); W0; W1; PIN(PW); SBAR(); }while(0)
  #define EX(v) __builtin_amdgcn_exp2f(v)
  #define GAPB(MF,X,B) do{ MF; X[B]=EX(X[B]); X[B+1]=EX(X[B+1]); PIN(X); SBAR(); }while(0)
  #define VRD(i) do{ vlo[i]=vtr(vp_+(((i)>>2)*4096+((i)&3)*1024)); vhi[i]=vtr(vp_+(((i)>>2)*4096+((i)&3)*1024+512)); }while(0)
  #define VRD2(i) do{ vlo[i]=vtr(vp_+(8192+((i)>>2)*4096+((i)&3)*1024)); vhi[i]=vtr(vp_+(8192+((i)>>2)*4096+((i)&3)*1024+512)); }while(0)
  #define KRD(G,j) do{ if(G){ kload2(kf,kp0+sl_next,j); SBAR(); } }while(0)
  #define STEP(C0,C1,P0,P1,t,GK,GV,GL) do{ SBAR(); \
    const lds_cptr vp_=vp0+2*sl_prev; \
    VRD(0); SBAR(); float sacc=(P0[0]+P0[1]); \
    GAPA(C0=__builtin_amdgcn_mfma_f32_32x32x16_bf16(kf[0],qr[0],negm,0,0,0), P0[2],P0[3],P0[4],P0[5],     pw0[0]=PKW(P0,0), pw0[1]=PKW(P0,2), pw0); \
    VRD(4); SBAR(); GAPA(C1=__builtin_amdgcn_mfma_f32_32x32x16_bf16(kf[1],qr[0],negm,0,0,0), P0[6],P0[7],P0[8],P0[9],     pw0[2]=PKW(P0,4), pw0[3]=PKW(P0,6), pw0); \
    VRD(1); SBAR(); GAPA(C0=__builtin_amdgcn_mfma_f32_32x32x16_bf16(kf[2],qr[1],C0,0,0,0),   P0[10],P0[11],P0[12],P0[13], pw1[0]=PKW(P0,8), pw1[1]=PKW(P0,10), pw1); \
    VRD(5); SBAR(); GAPA(C1=__builtin_amdgcn_mfma_f32_32x32x16_bf16(kf[3],qr[1],C1,0,0,0),   P0[14],P0[15],P1[0],P1[1],   pw1[2]=PKW(P0,12),pw1[3]=PKW(P0,14), pw1); \
    GAPA(C0=__builtin_amdgcn_mfma_f32_32x32x16_bf16(kf[4],qr[2],C0,0,0,0),   P1[2],P1[3],P1[4],P1[5],     pw2[0]=PKW(P1,0), pw2[1]=PKW(P1,2), pw2); \
    GAPA(C1=__builtin_amdgcn_mfma_f32_32x32x16_bf16(kf[5],qr[2],C1,0,0,0),   P1[6],P1[7],P1[8],P1[9],     pw2[2]=PKW(P1,4), pw2[3]=PKW(P1,6), pw2); \
    GAPA(C0=__builtin_amdgcn_mfma_f32_32x32x16_bf16(kf[6],qr[3],C0,0,0,0),   P1[10],P1[11],P1[12],P1[13], pw3[0]=PKW(P1,8), pw3[1]=PKW(P1,10), pw3); \
    GAPA(C1=__builtin_amdgcn_mfma_f32_32x32x16_bf16(kf[7],qr[3],C1,0,0,0),   P1[14],P1[15],0.f,0.f,       pw3[2]=PKW(P1,12),pw3[3]=PKW(P1,14), pw3); \
    l_reg+=sacc; \
    if(GK){DMA_K((t)+3,sl_cur);} if(GV){DMA_V((t)+1,sl_next);} \
    CMASK(C0,C1,t); \
    { float a=MX3(C0[0],C0[1],C1[0]),b=MX3(C0[2],C0[3],C1[1]); a=MX3(a,C1[2],C1[3]); \
      _Pragma("unroll") for(int r=4;r<16;r+=4){a=MX3(a,C0[r],C0[r+1]);b=MX3(b,C0[r+2],C0[r+3]);a=MX3(a,C1[r],C1[r+1]);b=MX3(b,C1[r+2],C1[r+3]);} \
      float rm=__builtin_fmaxf(a,b); { auto rr=__builtin_amdgcn_permlane32_swap(__float_as_uint(rm),__float_as_uint(rm),false,false); rm=__builtin_fmaxf(__uint_as_float(rr[0]),__uint_as_float(rr[1])); } \
      resc=false; \
      if(__builtin_expect(__any(rm>(float)THRL),0)){ const float dl=__builtin_fmaxf(rm,0.f); mhat+=dl; \
        _Pragma("unroll") for(int r=0;r<16;++r){C0[r]-=dl;C1[r]-=dl;} \
        _Pragma("unroll") for(int r=0;r<16;++r)negm[r]=-mhat; asm volatile("":"+v"(negm)); \
        const float f=__builtin_amdgcn_exp2f(-dl); l_reg*=f; if(hi==0)wsf[r32]=f; resc=true; } } \
    SBAR(); \
    VRD(2); SBAR(); GAPB(o[0]=__builtin_amdgcn_mfma_f32_32x32x16_bf16(PAF(0),VFR(0),o[0],0,0,0), C0,0); \
    VRD(6); SBAR(); GAPB(o[1]=__builtin_amdgcn_mfma_f32_32x32x16_bf16(PAF(0),VFR(4),o[1],0,0,0), C0,2); \
    VRD(3); SBAR(); KRD(GL,0); GAPB(o[0]=__builtin_amdgcn_mfma_f32_32x32x16_bf16(PAF(1),VFR(1),o[0],0,0,0), C0,4); \
    VRD(7); SBAR(); KRD(GL,1); GAPB(o[1]=__builtin_amdgcn_mfma_f32_32x32x16_bf16(PAF(1),VFR(5),o[1],0,0,0), C0,6); \
    VRD2(0); SBAR(); KRD(GL,2); GAPB(o[0]=__builtin_amdgcn_mfma_f32_32x32x16_bf16(PAF(2),VFR(2),o[0],0,0,0), C0,8); \
    VRD2(4); SBAR(); KRD(GL,3); GAPB(o[1]=__builtin_amdgcn_mfma_f32_32x32x16_bf16(PAF(2),VFR(6),o[1],0,0,0), C0,10); \
    VRD2(1); SBAR(); GAPB(o[0]=__builtin_amdgcn_mfma_f32_32x32x16_bf16(PAF(3),VFR(3),o[0],0,0,0), C0,12); \
    VRD2(5); SBAR(); GAPB(o[1]=__builtin_amdgcn_mfma_f32_32x32x16_bf16(PAF(3),VFR(7),o[1],0,0,0), C0,14); \
      \
    VRD2(2); SBAR(); GAPB(o[2]=__builtin_amdgcn_mfma_f32_32x32x16_bf16(PAF(0),VFR(0),o[2],0,0,0), C1,0); \
    VRD2(6); SBAR(); GAPB(o[3]=__builtin_amdgcn_mfma_f32_32x32x16_bf16(PAF(0),VFR(4),o[3],0,0,0), C1,2); \
    VRD2(3); SBAR(); GAPB(o[2]=__builtin_amdgcn_mfma_f32_32x32x16_bf16(PAF(1),VFR(1),o[2],0,0,0), C1,4); \
    VRD2(7); SBAR(); GAPB(o[3]=__builtin_amdgcn_mfma_f32_32x32x16_bf16(PAF(1),VFR(5),o[3],0,0,0), C1,6); \
    GAPB(o[2]=__builtin_amdgcn_mfma_f32_32x32x16_bf16(PAF(2),VFR(2),o[2],0,0,0), C1,8); \
    GAPB(o[3]=__builtin_amdgcn_mfma_f32_32x32x16_bf16(PAF(2),VFR(6),o[3],0,0,0), C1,10); \
    GAPB(o[2]=__builtin_amdgcn_mfma_f32_32x32x16_bf16(PAF(3),VFR(3),o[2],0,0,0), C1,12); \
    GAPB(o[3]=__builtin_amdgcn_mfma_f32_32x32x16_bf16(PAF(3),VFR(7),o[3],0,0,0), C1,14); \
    }while(0)
  int t=1;
  #undef CMASK
  #define CMASK(P0,P1,t) do{}while(0)
  for(;t+7<NT;t+=2){
    STEP(pB0,pB1,pA0,pA1,t,true,true,true);     WAIT_BAR(3); RESC(); ROT();
    STEP(pA0,pA1,pB0,pB1,t+1,true,true,true);   WAIT_BAR(3); RESC(); ROT();
  }
  #undef CMASK
  #define CMASK(P0,P1,t) do{ if((t)>=NT-6) bias_add(P0,P1,tabr,cb0+64*(t)); }while(0)
  #define ENDW(tt) do{ if((tt)+3<NT){WAIT_BAR(3);} else if((tt)+2<NT){WAIT_BAR(2);} else {WAIT_BAR(0);} }while(0)
  for(;t+1<NT;t+=2){
    STEP(pB0,pB1,pA0,pA1,t,(t+3<NT),(t+1<NT),(t+1<NT));       ENDW(t);   RESC(); ROT();
    STEP(pA0,pA1,pB0,pB1,t+1,(t+4<NT),(t+2<NT),(t+2<NT));     ENDW(t+1); RESC(); ROT();
  }
  STEP(pB0,pB1,pA0,pA1,NT-1,false,false,false); RESC();
  { float sacc=pB0[0]+pB0[1]; _Pragma("unroll") for(int r=2;r<16;++r)sacc+=pB0[r]; _Pragma("unroll") for(int r=0;r<16;++r)sacc+=pB1[r]; l_reg+=sacc;
    pw0=(u32x4){PKW(pB0,0),PKW(pB0,2),PKW(pB0,4),PKW(pB0,6)};pw1=(u32x4){PKW(pB0,8),PKW(pB0,10),PKW(pB0,12),PKW(pB0,14)};pw2=(u32x4){PKW(pB1,0),PKW(pB1,2),PKW(pB1,4),PKW(pB1,6)};pw3=(u32x4){PKW(pB1,8),PKW(pB1,10),PKW(pB1,12),PKW(pB1,14)};
    SBAR(); pv(o,(int)(uintptr_t)vp0+2*sl_cur,PAF(0),PAF(1),PAF(2),PAF(3)); pv(o+2,(int)(uintptr_t)vp0+2*sl_cur+8192,PAF(0),PAF(1),PAF(2),PAF(3)); }
  #undef PKW
  #undef PAF
  #undef VFR
  #undef PIN
  #undef MX3
  #undef GAPA
  #undef GAPB
  #undef EX
  #undef VRD
  #undef VRD2
  #undef KRD
  #undef STEP
  #undef ENDW
  {auto rr=__builtin_amdgcn_permlane32_swap(__float_as_uint(l_reg),__float_as_uint(l_reg),false,false);l_reg=__uint_as_float(rr[0])+__uint_as_float(rr[1]);}
  if(hi==0)wsf[32+r32]=l_reg;asm volatile("s_waitcnt lgkmcnt(0)":::"memory");
  float rli[16];
  #pragma unroll
  for(int r=0;r<16;++r)rli[r]=__builtin_amdgcn_rcpf(wsf[32+crow(r,hi)]);
  bf16*Ow=O+(rowbase+q0+wid*QBLK)*OPITCH+ocol;
  unsigned nxt=0u; const bool ldr=(wid==0&&lane==0); if(second&&ldr)nxt=__hip_atomic_fetch_add(qctr,1u,__ATOMIC_RELAXED,__HIP_MEMORY_SCOPE_AGENT);
  bf16*stg=(bf16*)(shm+LDS_OST)+wid*2048;
  if(!second){
    #pragma unroll
    for(int hp=0;hp<2;++hp){
      #pragma unroll
      for(int r=0;r<16;++r){const int orow=crow(r,hi);
        #pragma unroll
        for(int d0=0;d0<2;++d0)stg[orow*64+d0*32+r32]=__float2bfloat16(o[2*hp+d0][r]*rli[r]);}
      asm volatile("s_waitcnt lgkmcnt(0)":::"memory");
      #pragma unroll
      for(int i=0;i<4;++i){const int row=i*8+(lane>>3),ch=lane&7; const u32x4 v=*(const u32x4*)(stg+row*64+ch*8); ATTN_STORE16(Ow+(long)row*OPITCH+hp*64+ch*8,v);}
      asm volatile("s_waitcnt lgkmcnt(0)":::"memory"); }
  } else {
    const int ch=lane&7, rw=lane>>3; u32x4 z0[2][4]; const float lam=*lamp;
    #pragma unroll
    for(int hp=0;hp<2;++hp)
      #pragma unroll
      for(int i=0;i<4;++i)z0[hp][i]=*(const u32x4*)(Ow+(long)(i*8+rw)*OPITCH+hp*64+ch*8);
    float dd[2][4][8],ssr[4]={0.f,0.f,0.f,0.f};
    #pragma unroll
    for(int hp=0;hp<2;++hp){
      #pragma unroll
      for(int r=0;r<16;++r){const int orow=crow(r,hi);
        #pragma unroll
        for(int d0=0;d0<2;++d0)stg[orow*64+d0*32+r32]=__float2bfloat16(o[2*hp+d0][r]*rli[r]);}
      asm volatile("s_waitcnt lgkmcnt(0)":::"memory");
      #pragma unroll
      for(int i=0;i<4;++i){const u32x4 v=*(const u32x4*)(stg+(i*8+rw)*64+ch*8); const u32x4 w=z0[hp][i];
        #pragma unroll
        for(int e=0;e<4;++e){ const float x1l=__uint_as_float(v[e]<<16),x1h=__uint_as_float(v[e]&0xFFFF0000u),x0l=__uint_as_float(w[e]<<16),x0h=__uint_as_float(w[e]&0xFFFF0000u);
          const float dl=x0l-lam*x1l,dh=x0h-lam*x1h; dd[hp][i][2*e]=dl; dd[hp][i][2*e+1]=dh; ssr[i]+=dl*dl; ssr[i]+=dh*dh; } }
      asm volatile("s_waitcnt lgkmcnt(0)":::"memory"); }
    float gsub[2][8];
    #pragma unroll
    for(int hp=0;hp<2;++hp)
      #pragma unroll
      for(int e=0;e<8;++e)gsub[hp][e]=subg[hp*64+ch*8+e]*0.8f;
    bf16*Pw=PQ+(rowbase+q0+wid*QBLK)*(long)DM+pqcol;
    #pragma unroll
    for(int i=0;i<4;++i){ float ss=ssr[i]; ss+=__shfl_xor(ss,1); ss+=__shfl_xor(ss,2); ss+=__shfl_xor(ss,4);
      const float rstd=1.0f/sqrtf(ss*(1.0f/128.0f)+1e-6f);
      #pragma unroll
      for(int hp=0;hp<2;++hp){ u32x4 ov;
        #pragma unroll
        for(int e=0;e<4;++e)ov[e]=cvtpk_s(dd[hp][i][2*e]*rstd*gsub[hp][2*e],dd[hp][i][2*e+1]*rstd*gsub[hp][2*e+1]);
        ATTN_STORE16(Pw+(long)(i*8+rw)*DM+hp*64+ch*8,ov); } }
  }
  if(second&&ldr)slot[0]=nxt;
  asm volatile("s_waitcnt lgkmcnt(0)\n\ts_barrier":::"memory");
  #undef DMA_K
  #undef DMA_V
  #undef CMASK
  #undef START
  #undef RESC
  #undef ROT
}
constexpr int ATTN_LDS_BYTES=LDS_BYTES;
struct AttnArgs { const bf16* P; bf16* O; const float* tab; unsigned* qctr; };
#undef SBAR
#undef WAIT_BAR
}

#define GAS __attribute__((address_space(1)))
#define LAS __attribute__((address_space(3)))
typedef unsigned short bf16;
typedef unsigned v4u __attribute__((ext_vector_type(4)));
typedef float f32x4 __attribute__((ext_vector_type(4)));
typedef short bf16x8 __attribute__((ext_vector_type(8)));
typedef GAS unsigned gu32;
typedef GAS unsigned long long gu64;
#define RLX_AGENT __ATOMIC_RELAXED, __HIP_MEMORY_SCOPE_AGENT
#define LDS_WAIT() asm volatile("s_waitcnt lgkmcnt(0)" ::: "memory")
#define VM_WAIT() asm volatile("s_waitcnt vmcnt(0)" ::: "memory")
__device__ __forceinline__ unsigned long long rt() { return __builtin_amdgcn_s_memrealtime(); }
__device__ __forceinline__ unsigned f2bf(float f) { unsigned u = __builtin_bit_cast(unsigned, f); return (u + 0x7fffu + ((u >> 16) & 1u)) >> 16; }
__device__ __forceinline__ unsigned pk2(float lo, float hi) { return f2bf(lo) | (f2bf(hi) << 16); }

#define XB_TMO      128
#define XB_XCNT(j)  (256  + 64 * (j))
#define XB_XSUB(j)  (1280 + 64 * (j))
#define XB_XGEN(j)  (2304 + 64 * (j))
#define XB_TOP      3328
#define XB_TOPGEN   3392
#define XCD_BAR_WORDS 3456
#define XB_SPIN_CAP (1u << 18)

__device__ __forceinline__ unsigned xb_ld(unsigned* p)              { return __hip_atomic_load(p, __ATOMIC_RELAXED, __HIP_MEMORY_SCOPE_AGENT); }
__device__ __forceinline__ unsigned xb_add(unsigned* p, unsigned v) { return __hip_atomic_fetch_add(p, v, __ATOMIC_RELAXED, __HIP_MEMORY_SCOPE_AGENT); }
__device__ __forceinline__ unsigned xb_xcc_id() { return (unsigned)__builtin_amdgcn_s_getreg((3 << 11) | 20) & 0xFu; }
#define XB_SPIN(cond, bar) do { unsigned _sp = 0; while (cond) { __builtin_amdgcn_s_sleep(1); \
    if ((++_sp & 255u) == 0u) { if (xb_ld(&(bar)[XB_TMO])) break; if (_sp > XB_SPIN_CAP) { atomicAdd(&(bar)[XB_TMO], 1u); break; } } } } while (0)

struct XcdBarrier {
    unsigned* bar; unsigned x;
    volatile LAS unsigned* st;
};

__device__ __forceinline__ XcdBarrier xcd_barrier_post(unsigned* bar, volatile LAS unsigned* st, const bool leader) {
    XcdBarrier b; b.bar = bar; b.x = xb_xcc_id(); b.st = st;
    if (leader) (void)xb_add(&bar[XB_XCNT(b.x)], 1u);
    return b;
}
__device__ __forceinline__ void xcd_barrier_complete(unsigned* bar, unsigned x, unsigned& nloc, unsigned& nx) {
    const unsigned G = gridDim.x * gridDim.y * gridDim.z;
    unsigned sum, cnt, mine, sp = 0u;
    for (;;) {
        sum = 0u; cnt = 0u; mine = 0u;
#pragma unroll
        for (unsigned j = 0; j < 16; ++j) { const unsigned c = xb_ld(&bar[XB_XCNT(j)]); sum += c; cnt += (c > 0u) ? 1u : 0u; mine = (j == x) ? c : mine; }
        if (sum == G) break;
        __builtin_amdgcn_s_sleep(1);
        if ((++sp & 255u) == 0u) { if (xb_ld(&bar[XB_TMO])) break; if (sp > XB_SPIN_CAP) { atomicAdd(&bar[XB_TMO], 1u); break; } }
    }
    nloc = mine > 0u ? mine : 1u; nx = cnt > 0u ? cnt : 1u;
}

__device__ __forceinline__ void xcd_barrier(const XcdBarrier& b, const bool leader) {
    asm volatile("s_waitcnt vmcnt(0)" ::: "memory");
    __syncthreads();
    if (leader) {
        unsigned* bar = b.bar;
        __builtin_amdgcn_s_waitcnt(0);
        unsigned nloc = b.st[0], nx = b.st[1];
        if (nloc == 0u) { xcd_barrier_complete(bar, b.x, nloc, nx); b.st[0] = nloc; b.st[1] = nx; }
        const unsigned old = xb_add(&bar[XB_XSUB(b.x)], 1u);
        const unsigned gen = old / nloc;
        if (old + 1u == (gen + 1u) * nloc) {
            __builtin_amdgcn_fence(__ATOMIC_RELEASE, "agent");
            asm volatile("s_waitcnt vmcnt(0)" ::: "memory");
            const unsigned og = xb_add(&bar[XB_TOP], 1u);
            const unsigned tg = og / nx;
            if (og + 1u == (tg + 1u) * nx) xb_add(&bar[XB_TOPGEN], 1u);
            else XB_SPIN(xb_ld(&bar[XB_TOPGEN]) == tg, bar);
            __builtin_amdgcn_fence(__ATOMIC_ACQUIRE, "agent");
            xb_add(&bar[XB_XGEN(b.x)], 1u);
            asm volatile("s_waitcnt vmcnt(0)" ::: "memory");
        } else {
            XB_SPIN(xb_ld(&bar[XB_XGEN(b.x)]) == gen, bar);
            __builtin_amdgcn_fence(__ATOMIC_ACQUIRE, "agent");
            asm volatile("s_waitcnt vmcnt(0)" ::: "memory");
        }
    }
    __syncthreads();
}

constexpr int NWAVES = 8;
constexpr int BATCH = 4, SEQ = 4096, DMODEL = 2048, M = BATCH * SEQ;
constexpr int NP = 6912;
constexpr int PC_K = 0, PC_V = 1024, PC_Q = 2048, PC_R = 3072, PC_KR = 4096, PC_VR = 5120;
constexpr int PC_W1A = 6144, PC_W1B = 6208, PC_A1A = 6272, PC_A1B = 6336, PC_G1A = 6400, PC_G1B = 6560, PC_PAD = 6720;
constexpr int DFF = 5632, NUP = 2 * DFF, KL2 = 384, NL2 = 3072;
constexpr int ADA_T0 = 128;
constexpr float NORM_EPS = 1e-6f, GN_EPS = 64e-5f, LOG2E = 1.4426950408889634f;
constexpr float QSCALE = 0.125f * LOG2E;
enum { I_X = 0, I_C, I_RELB, I_WADA, I_BADA, I_NMG, I_WIN, I_QNG, I_KNG, I_LQ1, I_LK1, I_LQ2, I_LK2, I_SUBG, I_MURKV, I_MUWAG, I_W0, I_W1, I_W2, I_A0, I_A1, I_A2, I_G1, I_G2,
       I_KK, I_KA, I_RK, I_LNG, I_LNB, I_WOUT, I_NFG, I_WUP, I_CW, I_CB, I_WDN, N_IN };

constexpr size_t MiB = 1u << 20;
constexpr size_t WS_CTL = 0, CTL_ZERO_BYTES = 64 * 1024;
constexpr size_t WS_MODA = 64 * 1024;
constexpr size_t WS_MOD = 1 * MiB;
constexpr size_t WS_BIASF = 1 * MiB + 256 * 1024;
constexpr size_t WS_ROWSS = 1 * MiB + 512 * 1024;
constexpr size_t WS_ATAB = 1 * MiB + 640 * 1024;
constexpr size_t WS_LAM = 1 * MiB + 704 * 1024;
constexpr size_t WS_GSF = 1 * MiB + 768 * 1024;
constexpr size_t WS_GSM = 1 * MiB + 800 * 1024;
constexpr size_t WS_WDN = 4 * MiB, WS_WUP = 26 * MiB, WS_H = 70 * MiB, WS_WOUT = 134 * MiB, WS_WIN = 142 * MiB, WS_WL2 = 169 * MiB;
constexpr size_t WS_P = 172 * MiB, WS_LA = 388 * MiB, WS_L2 = 400 * MiB, WS_MODP = 496 * MiB;
constexpr size_t WS_X1B = WS_L2;
constexpr size_t WS_OBUF = WS_H, WS_XG = WS_H, WS_ACT = 160 * MiB, WS_UPH = 336 * MiB, WS_HALO = 348 * MiB, WS_END = 512 * MiB;
static_assert(WS_WIN + (size_t)NP * 2048 * 2 <= WS_WL2 && WS_WL2 + (size_t)NL2 * KL2 * 2 <= WS_P && WS_P + (size_t)M * NP * 2 <= WS_LA && WS_LA + (size_t)M * KL2 * 2 <= WS_L2 && WS_L2 + (size_t)M * NL2 * 2 <= WS_MODP, "ws map 1");
static_assert(WS_ACT + (size_t)M * DFF * 2 <= WS_UPH && WS_UPH + (size_t)256 * NUP * 4 <= WS_HALO && WS_HALO + (size_t)256 * NUP * 4 <= WS_END && WS_WUP + (size_t)NUP * 2048 * 2 <= WS_H && WS_WDN + (size_t)2048 * DFF * 2 <= WS_WUP, "ws map 2");
constexpr int CW_BAR = 4096;
constexpr int CW_ATTQ = 64;

constexpr int RING_OFF = 0, RING_BYTES = 131072;
constexpr int LDSCTL_OFF = 143360, MISC_OFF = LDSCTL_OFF + 320;
constexpr int LDS_BYTES = 147456;

struct Frame {
    LAS unsigned char* lds;
    volatile LAS unsigned* MISC;
    gu32* ctl;
    int wave, vcu, G;
    float* out; unsigned char* ws;
};
typedef const float* mk_fptr;
__device__ __forceinline__ const float* inp(int k) {
    const __attribute__((address_space(4))) mk_fptr* t = (const __attribute__((address_space(4))) mk_fptr*)__builtin_amdgcn_kernarg_segment_ptr(); asm volatile("" : "+s"(t));
    return (const float*)(const __attribute__((address_space(1))) float*)t[k];
}
__device__ __forceinline__ float wave_sum(float v) {
#pragma unroll
    for (int o = 1; o < 64; o <<= 1) v += __shfl_xor(v, o);
    return v;
}
__device__ __forceinline__ float bf2f(unsigned short h) { return __uint_as_float((unsigned)h << 16); }
__device__ __forceinline__ float bflo(unsigned w) { return __uint_as_float(w << 16); }
__device__ __forceinline__ float bfhi(unsigned w) { return __uint_as_float(w & 0xffff0000u); }
__device__ __forceinline__ float sigm(float x) { return 1.0f / (1.0f + __expf(-x)); }

__device__ __forceinline__ void transpose_item(const float* W, int ldw, bf16* WT, int ldt, int k0, int n0, int drow0, const float* mu, int smode, LAS float* scr, int lane) {
    const int r8 = lane >> 3, c4 = (lane & 7) * 4; f32x4 v[8];
#pragma unroll
    for (int i = 0; i < 8; ++i) v[i] = *(const GAS f32x4*)(W + (size_t)(k0 + 8 * i + r8) * ldw + n0 + c4);
    if (smode) {
#pragma unroll
        for (int i = 0; i < 8; ++i) { const float m = mu[k0 + 8 * i + r8]; v[i] = v[i] * ((smode == 1) ? (1.0f - m) : m); } }
#pragma unroll
    for (int i = 0; i < 8; ++i) { LAS float* d = scr + (8 * i + r8) * 33 + c4; d[0] = v[i].x; d[1] = v[i].y; d[2] = v[i].z; d[3] = v[i].w; }
    LDS_WAIT(); asm volatile("" ::: "memory");
    const int c = lane & 7;
#pragma unroll
    for (int j = 0; j < 4; ++j) { const int n = (lane >> 3) + 8 * j; const LAS float* s = scr + (8 * c) * 33 + n;
        v4u o; o.x = pk2(s[0 * 33], s[1 * 33]); o.y = pk2(s[2 * 33], s[3 * 33]); o.z = pk2(s[4 * 33], s[5 * 33]); o.w = pk2(s[6 * 33], s[7 * 33]);
        *(GAS v4u*)(WT + (size_t)(drow0 + n) * ldt + k0 + 8 * c) = o; }
    LDS_WAIT(); asm volatile("" ::: "memory");
}
__device__ __forceinline__ int t5_bucket(int n) {
    if (n < 16) return n;
    int large = 16 + (int)(logf((float)n / 16.0f) / logf(8.0f) * 16.0f);
    return large < 31 ? large : 31;
}
__device__ __forceinline__ void p0_prologue(Frame& F) {
    LAS float* scr = (LAS float*)(F.lds + RING_OFF + F.wave * 16384);
    const int gw = F.vcu * NWAVES + F.wave, NGW = F.G * NWAVES, lane = mk_lane_id();
    bf16* WIN_T = (bf16*)(F.ws + WS_WIN); bf16* WOUT_T = (bf16*)(F.ws + WS_WOUT); bf16* WUP_T = (bf16*)(F.ws + WS_WUP); bf16* WDN_T = (bf16*)(F.ws + WS_WDN); bf16* WL2_T = (bf16*)(F.ws + WS_WL2);
    const float* mu_wag = inp(I_MUWAG);
    {
        float* moda = (float*)(F.ws + WS_MODA); const float* wada = inp(I_WADA); const float* c = inp(I_C); const float* bada = inp(I_BADA);
        LAS float* sc = (LAS float*)(F.lds + RING_OFF); LAS float* red = sc + 8192;
        for (int t = F.vcu; t < ADA_T0; t += F.G) {
            for (int i = F.wave * 64 + lane; i < 8192; i += NWAVES * 64) { const float x = c[i]; sc[i] = x * sigm(x); }
            const int rs = lane >> 3, cq = lane & 7; const float* wp = wada + (size_t)(256 * F.wave + rs) * 12288 + 32 * t + 4 * cq;
            f32x4 wv[32];
#pragma unroll
            for (int i = 0; i < 32; ++i) wv[i] = *(const GAS f32x4*)(wp + (size_t)(8 * i) * 12288);
            __syncthreads();
            f32x4 a[4] = {{0.f, 0.f, 0.f, 0.f}, {0.f, 0.f, 0.f, 0.f}, {0.f, 0.f, 0.f, 0.f}, {0.f, 0.f, 0.f, 0.f}};
#pragma unroll
            for (int i = 0; i < 32; ++i) { const int kk = 256 * F.wave + 8 * i + rs;
#pragma unroll
                for (int b = 0; b < 4; ++b) a[b] += wv[i] * sc[b * 2048 + kk]; }
#pragma unroll
            for (int b = 0; b < 4; ++b)
#pragma unroll
                for (int e = 0; e < 4; ++e) { float v = a[b][e]; v += __shfl_xor(v, 8); v += __shfl_xor(v, 16); v += __shfl_xor(v, 32); a[b][e] = v; }
            if (rs == 0) {
#pragma unroll
                for (int b = 0; b < 4; ++b) *(LAS f32x4*)(red + (F.wave * 4 + b) * 32 + 4 * cq) = a[b]; }
            __syncthreads();
            { const int tid = F.wave * 64 + lane; if (tid < 128) { const int b = tid >> 5, cc = tid & 31, col = 32 * t + cc; float s = bada[col];
#pragma unroll
                for (int w = 0; w < 8; ++w) s += red[(w * 4 + b) * 32 + cc];
                moda[b * 4096 + col] = s; } }
            __syncthreads();
        }
    }
    constexpr int I_IN = 32 * 192, I_L = 32 * 2, I_LG = 32 * 5, I_LORA = 4 * I_L + 2 * I_LG, I_OUT = 32 * 64, I_UP = 32 * 352, I_DN = 88 * 64;
    constexpr int NITEMS = I_IN + I_LORA;
    for (int it = gw; it < NITEMS; it += NGW) {
        int r = it;
        if (r < I_IN) { const int kb = r / 192, nb = r % 192, n0 = 32 * nb, blk = n0 >> 10; int drow = (blk == 0 ? PC_Q : blk == 1 ? PC_K : blk == 2 ? PC_V : blk * 1024) + (n0 & 1023);
            if (blk < 2) { const int l = drow & 255; drow = (drow & ~255) + 128 * ((l >> 5) & 1) + 32 * (l >> 6); }
            transpose_item(inp(I_WIN), 6144, WIN_T, 2048, 64 * kb, n0, drow, nullptr, 0, scr, lane); continue; } r -= I_IN;
        if (r < I_LORA) {
            if (r < 2 * I_L) { const int v = r / I_L, q = r % I_L; transpose_item(inp(I_W1), 64, WIN_T, 2048, 64 * (q / 2), 32 * (q % 2), (v ? PC_W1B : PC_W1A) + 32 * (q % 2), mu_wag, 1 + v, scr, lane); continue; } r -= 2 * I_L;
            if (r < 2 * I_L) { const int v = r / I_L, q = r % I_L; transpose_item(inp(I_A1), 64, WIN_T, 2048, 64 * (q / 2), 32 * (q % 2), (v ? PC_A1B : PC_A1A) + 32 * (q % 2), mu_wag + 2048, 1 + v, scr, lane); continue; } r -= 2 * I_L;
            { const int v = r / I_LG, q = r % I_LG; transpose_item(inp(I_G1), 160, WIN_T, 2048, 64 * (q / 5), 32 * (q % 5), (v ? PC_G1B : PC_G1A) + 32 * (q % 5), mu_wag + 4096, 1 + v, scr, lane); continue; }
        } r -= I_LORA;
    }
    const int gt = (F.vcu * NWAVES + F.wave) * 64 + lane, NGT = NGW * 64;
    for (int i = gt; i < (NP - PC_PAD) * 2048 / 8; i += NGT) *(GAS v4u*)(WIN_T + (size_t)PC_PAD * 2048 + (size_t)i * 8) = (v4u){0u, 0u, 0u, 0u};
    const float* w2p = inp(I_W2); const float* a2p = inp(I_A2); const float* g2p = inp(I_G2);
    for (int i = gt; i < NL2 * KL2 / 8; i += NGT) {
        const int n = i % NL2, k0 = (i / NL2) * 8, kind = n >> 10, nl = n & 1023; float v[8] = {0.f, 0.f, 0.f, 0.f, 0.f, 0.f, 0.f, 0.f};
        const float* src = kind == 0 ? w2p : kind == 1 ? a2p - (size_t)64 * 1024 : g2p - (size_t)128 * 1024;
        const int lo = kind == 0 ? 0 : kind == 1 ? 64 : 128, hi = kind == 0 ? 64 : kind == 1 ? 128 : 288;
        if (k0 >= lo && k0 < hi) {
#pragma unroll
            for (int e = 0; e < 8; ++e) v[e] = src[(size_t)(k0 + e) * 1024 + nl]; }
        v4u o; o.x = pk2(v[0], v[1]); o.y = pk2(v[2], v[3]); o.z = pk2(v[4], v[5]); o.w = pk2(v[6], v[7]);
        *(GAS v4u*)(WL2_T + (size_t)n * KL2 + k0) = o;
    }
    { float* rowss = (float*)(F.ws + WS_ROWSS); for (int i = gt; i < M; i += NGT) rowss[i] = 0.f; }
    { float* atab = (float*)(F.ws + WS_ATAB); const float* relb = inp(I_RELB);
        for (int i = gt; i < 8 * 640; i += NGT) { const int h = i / 640, j = i % 640, d = 383 - j;
            atab[i] = d < 0 ? -INFINITY : (relb[t5_bucket(d) * 8 + h] - relb[31 * 8 + h]) * LOG2E; } }
    if (gt == 0) { const float* q1 = inp(I_LQ1); const float* k1 = inp(I_LK1); const float* q2 = inp(I_LQ2); const float* k2 = inp(I_LK2); float s1 = 0.f, s2 = 0.f; for (int i = 0; i < 64; ++i) { s1 += q1[i] * k1[i]; s2 += q2[i] * k2[i]; }
        *(float*)(F.ws + WS_LAM) = expf(s1) - expf(s2) + 0.2f; }
}
typedef float f32x2_lm __attribute__((ext_vector_type(2)));
constexpr int N_LATE_UNITS = 64;
__device__ __forceinline__ void p3_late_mod(Frame& F, const int q) {
    const int lane = mk_lane_id(), wave = F.wave, col0 = 4096 + 128 * q;
    const float* wada = inp(I_WADA); const float* c = inp(I_C); LAS float* red = (LAS float*)(F.lds + RING_OFF);
    f32x2_lm a0 = {0.f, 0.f}, a1 = a0, a2 = a0, a3 = a0;
    const float* wp = wada + (size_t)(256 * wave) * 12288 + col0 + 2 * lane;
    float cs[4][4];
#pragma unroll
    for (int r = 0; r < 4; ++r)
#pragma unroll
        for (int b = 0; b < 4; ++b) { const float x = c[b * 2048 + 256 * wave + 64 * r + lane]; cs[r][b] = x * sigm(x); }
#pragma unroll
    for (int r = 0; r < 4; ++r) {
#pragma unroll 1
        for (int k0 = 0; k0 < 64; k0 += 16) {
            f32x2_lm wv[16];
#pragma unroll
            for (int i = 0; i < 16; ++i) wv[i] = *(const GAS f32x2_lm*)(wp + (size_t)(64 * r + k0 + i) * 12288);
            asm volatile("" ::: "memory");
#pragma unroll
            for (int i = 0; i < 16; ++i) { const int ln = k0 + i;
                const float s0 = __int_as_float(__builtin_amdgcn_readlane(__float_as_int(cs[r][0]), ln)), s1 = __int_as_float(__builtin_amdgcn_readlane(__float_as_int(cs[r][1]), ln));
                const float s2 = __int_as_float(__builtin_amdgcn_readlane(__float_as_int(cs[r][2]), ln)), s3 = __int_as_float(__builtin_amdgcn_readlane(__float_as_int(cs[r][3]), ln));
                a0 += wv[i] * s0; a1 += wv[i] * s1; a2 += wv[i] * s2; a3 += wv[i] * s3; }
        }
    }
    __syncthreads();
    { LAS f32x2_lm* r2 = (LAS f32x2_lm*)(red + (size_t)wave * 512) + lane; r2[0] = a0; r2[64] = a1; r2[128] = a2; r2[192] = a3; }
    __syncthreads();
    { const int tid = wave * 64 + lane, b = tid >> 7, cc = tid & 127, col = col0 + cc; float s = inp(I_BADA)[col];
#pragma unroll
      for (int p = 0; p < 8; ++p) s += red[p * 512 + b * 128 + cc];
      ((float*)(F.ws + WS_MOD))[(size_t)b * 12288 + col] = s;
      if (col >= 8192 && col < 10240) ((float*)(F.ws + WS_GSF))[b * 2048 + (col - 8192)] = inp(I_NFG)[col - 8192] * (1.0f + s); }
    __syncthreads();
}
__device__ __forceinline__ void p1_hnorm(Frame& F) {
    const int gw = F.vcu * NWAVES + F.wave, NGW = F.G * NWAVES, lane = mk_lane_id();
    const float* moda = (const float*)(F.ws + WS_MODA); const float* nmg = inp(I_NMG); const float* xin = inp(I_X); bf16* H = (bf16*)(F.ws + WS_H);
    const int PPW = (M / 2 + NGW - 1) / NGW; int bcur = -1; f32x4 gg[8], sh[8];
    for (int p = gw * PPW; p < (gw + 1) * PPW && p < M / 2; ++p) {
        const int m = 2 * p, b = m >> 12;
        if (b != bcur) { bcur = b;
#pragma unroll
            for (int j = 0; j < 8; ++j) { const int c = 4 * lane + 256 * j;
                sh[j] = *(const GAS f32x4*)(moda + (size_t)b * 4096 + c);
                gg[j] = *(const GAS f32x4*)(nmg + c) * (1.0f + *(const GAS f32x4*)(moda + (size_t)b * 4096 + 2048 + c)); } }
        const GAS f32x4* xr = (const GAS f32x4*)(xin + (size_t)m * 2048) + lane;
        f32x4 v0[8], v1[8];
#pragma unroll
        for (int j = 0; j < 8; ++j) { v0[j] = xr[64 * j]; v1[j] = xr[512 + 64 * j]; }
        float s0 = 0.f, s1 = 0.f;
#pragma unroll
        for (int j = 0; j < 8; ++j) { s0 += (v0[j].x * v0[j].x + v0[j].y * v0[j].y) + (v0[j].z * v0[j].z + v0[j].w * v0[j].w); s1 += (v1[j].x * v1[j].x + v1[j].y * v1[j].y) + (v1[j].z * v1[j].z + v1[j].w * v1[j].w); }
        const float r0 = 1.0f / sqrtf(wave_sum(s0) * (1.0f / 2048.0f) + NORM_EPS), r1 = 1.0f / sqrtf(wave_sum(s1) * (1.0f / 2048.0f) + NORM_EPS);
        GAS unsigned long long* o8 = (GAS unsigned long long*)(H + (size_t)m * 2048) + lane;
#pragma unroll
        for (int j = 0; j < 8; ++j) { const f32x4 y0 = v0[j] * r0 * gg[j] + sh[j], y1 = v1[j] * r1 * gg[j] + sh[j];
            o8[64 * j] = (unsigned long long)pk2(y0.x, y0.y) | ((unsigned long long)pk2(y0.z, y0.w) << 32);
            o8[512 + 64 * j] = (unsigned long long)pk2(y1.x, y1.y) | ((unsigned long long)pk2(y1.z, y1.w) << 32); }
    }
}
__device__ __forceinline__ void p3_prep(Frame& F) {
    const int gw = F.vcu * NWAVES + F.wave, NGW = F.G * NWAVES, lane = mk_lane_id();
    const bf16* P = (const bf16*)(F.ws + WS_P); bf16* LA = (bf16*)(F.ws + WS_LA);
    const int j0 = 8 * lane; int ca = 0, cb = 0, kind = 3;
    if (j0 < 64) { ca = PC_W1A + j0; cb = PC_W1B + j0; kind = 0; } else if (j0 < 128) { ca = PC_A1A + j0 - 64; cb = PC_A1B + j0 - 64; kind = 1; } else if (j0 < 288) { ca = PC_G1A + j0 - 128; cb = PC_G1B + j0 - 128; kind = 2; }
    const int RPW = (M + NGW - 1) / NGW, mend = (gw + 1) * RPW < M ? (gw + 1) * RPW : M;
    for (int m0 = gw * RPW; m0 < mend; m0 += 4) {
        v4u a[4], b[4];
#pragma unroll
        for (int r = 0; r < 4; ++r) { const int m = m0 + r; a[r] = (v4u){0u, 0u, 0u, 0u}; b[r] = a[r];
            if (m < mend && kind < 3) { a[r] = *(const GAS v4u*)(P + (size_t)m * NP + ca); if ((m & (SEQ - 1)) != 0) b[r] = *(const GAS v4u*)(P + (size_t)(m - 1) * NP + cb); } }
#pragma unroll
        for (int r = 0; r < 4; ++r) { const int m = m0 + r; const float x[8] = {bflo(a[r].x), bfhi(a[r].x), bflo(a[r].y), bfhi(a[r].y), bflo(a[r].z), bfhi(a[r].z), bflo(a[r].w), bfhi(a[r].w)}, y[8] = {bflo(b[r].x), bfhi(b[r].x), bflo(b[r].y), bfhi(b[r].y), bflo(b[r].z), bfhi(b[r].z), bflo(b[r].w), bfhi(b[r].w)}; float o[8];
#pragma unroll
            for (int e = 0; e < 8; ++e) { const float v = x[e] + y[e]; const float s = sigm(kind == 0 ? 2.0f * v : v);
                o[e] = kind == 0 ? 2.0f * s - 1.0f : kind == 1 ? v : kind == 2 ? s : 0.f; }
            if (m < mend && lane < KL2 / 8) { v4u w; w.x = pk2(o[0], o[1]); w.y = pk2(o[2], o[3]); w.z = pk2(o[4], o[5]); w.w = pk2(o[6], o[7]); *(GAS v4u*)(LA + (size_t)m * KL2 + j0) = w; } }
    }
}
template <int CTRL> __device__ __forceinline__ float dpp_mov0(float x) { return __int_as_float(__builtin_amdgcn_update_dpp(0, __float_as_int(x), CTRL, 0xF, 0xF, true)); }
template <int CTRL> __device__ __forceinline__ float dpp_add(float x) { return x + dpp_mov0<CTRL>(x); }
__device__ __forceinline__ float red4(float x) { x = dpp_add<0xB1>(x); x = dpp_add<0x4E>(x); return x; }
constexpr size_t YRAW_OFF = 0, BON_OFF = (size_t)M * 1024 * 4;
__device__ __forceinline__ void unpack8(const v4u w, float* x) { x[0] = bflo(w.x); x[1] = bfhi(w.x); x[2] = bflo(w.y); x[3] = bfhi(w.y); x[4] = bflo(w.z); x[5] = bfhi(w.z); x[6] = bflo(w.w); x[7] = bfhi(w.w); }
__device__ __forceinline__ void ld8f(const float* p, float* x) { const f32x4 a = *(const GAS f32x4*)p, b = *(const GAS f32x4*)(p + 4); x[0] = a.x; x[1] = a.y; x[2] = a.z; x[3] = a.w; x[4] = b.x; x[5] = b.y; x[6] = b.z; x[7] = b.w; }
typedef unsigned v2u __attribute__((ext_vector_type(2)));
typedef short s16x4 __attribute__((ext_vector_type(4)));
constexpr int CK_STR = 144;
constexpr int CK_IMG = 16 * CK_STR;
constexpr int CK_QK = 0, CK_QR = CK_IMG, CK_KB = 2 * CK_IMG, CK_KK = 3 * CK_IMG, CK_V = 4 * CK_IMG, CK_AK = 5 * CK_IMG, CK_BR = CK_AK + 512, CK_KR = CK_BR + 512, CK_TP = CK_KR + 512, CK_GAM = CK_TP + 512, CK_AB = CK_GAM + 256, CK_SLOT = CK_AB + 1024;
constexpr int CK_NSLOT = 8, CK_CONST = CK_NSLOT * CK_SLOT, CK_END = CK_CONST + 8 * 1536;
#ifndef MK_PRE0
#define MK_PRE0 256
#endif
constexpr int CK_IMG_BYTES = 14336, CK_PRE0 = MK_PRE0;
static_assert(CK_END <= 143360, "scan LDS map");
typedef float ck_f32x2 __attribute__((ext_vector_type(2))); typedef __bf16 ck_bf16x2 __attribute__((ext_vector_type(2)));
__device__ __forceinline__ unsigned pk2f(float lo, float hi) { const ck_f32x2 v = {lo, hi}; return __builtin_bit_cast(unsigned, __builtin_convertvector(v, ck_bf16x2)); }
__device__ __forceinline__ void st16bf(LAS unsigned char* p, const float* x) {
    v4u a, b; a.x = pk2f(x[0], x[1]); a.y = pk2f(x[2], x[3]); a.z = pk2f(x[4], x[5]); a.w = pk2f(x[6], x[7]); b.x = pk2f(x[8], x[9]); b.y = pk2f(x[10], x[11]); b.z = pk2f(x[12], x[13]); b.w = pk2f(x[14], x[15]);
    *(LAS v4u*)p = a; *(LAS v4u*)(p + 16) = b;
}
struct CkRaw { v4u r[2], k[2], v[2], rp[2], kp[2], vp[2], lw[2], a[2]; };
__device__ __forceinline__ void ck_fetch(CkRaw& R, const bf16* P, const bf16* L2, const size_t m0, const int c, const int h, const int lane) {
    const int q = lane >> 4, j = lane & 15, ch = h * 64 + 16 * q; const int s = 16 * c + j; const size_t m = m0 + s; const bf16* pr = P + m * NP;
#pragma unroll
    for (int i = 0; i < 2; ++i) { R.r[i] = *(const GAS v4u*)(pr + PC_R + ch + 8 * i); R.k[i] = *(const GAS v4u*)(pr + PC_KR + ch + 8 * i); R.v[i] = *(const GAS v4u*)(pr + PC_VR + ch + 8 * i);
        R.rp[i] = (v4u){0u, 0u, 0u, 0u}; R.kp[i] = R.rp[i]; R.vp[i] = R.rp[i]; }
    if (s > 0) {
#pragma unroll
        for (int i = 0; i < 2; ++i) { R.rp[i] = *(const GAS v4u*)(pr - NP + PC_R + ch + 8 * i); R.kp[i] = *(const GAS v4u*)(pr - NP + PC_KR + ch + 8 * i); R.vp[i] = *(const GAS v4u*)(pr - NP + PC_VR + ch + 8 * i); } }
    const bf16* l2 = L2 + m * NL2;
#pragma unroll
    for (int i = 0; i < 2; ++i) { R.lw[i] = *(const GAS v4u*)(l2 + ch + 8 * i); R.a[i] = *(const GAS v4u*)(l2 + 1024 + ch + 8 * i); }
}
__device__ __forceinline__ void ck_ld16(const LAS float* p, float* x) {
#pragma unroll
    for (int e = 0; e < 4; ++e) { const f32x4 t4 = *(const LAS f32x4*)(p + 4 * e); x[4 * e] = t4.x; x[4 * e + 1] = t4.y; x[4 * e + 2] = t4.z; x[4 * e + 3] = t4.w; }
}
template <int PV = 0> __device__ __forceinline__ void ck_produce(const CkRaw& R, LAS unsigned char* S, const LAS float* CN, float* bonus, const size_t m0, const int c, const int h, const int lane) {
    const int q = lane >> 4, j = lane & 15, c0 = 16 * q; const size_t m = m0 + 16 * c + j;
    float r[16], k[16], v[16], aa[16], lw[16];
    {
        float cur[16], prv[16], mu[16];
#define CK_MIX(dst, CUR, PRV, MUOFF) do { unpack8(CUR[0], cur); unpack8(CUR[1], cur + 8); unpack8(PRV[0], prv); unpack8(PRV[1], prv + 8); ck_ld16(CN + (MUOFF) + c0, mu); \
        _Pragma("unroll") for (int e = 0; e < 16; ++e) dst[e] = cur[e] + (prv[e] - cur[e]) * mu[e]; } while (0)
        CK_MIX(r, R.r, R.rp, 0); CK_MIX(k, R.k, R.kp, 64); CK_MIX(v, R.v, R.vp, 128);
#undef CK_MIX
        unpack8(R.lw[0], lw); unpack8(R.lw[1], lw + 8); unpack8(R.a[0], aa); unpack8(R.a[1], aa + 8);
    }
    const int ro = j * CK_STR + 32 * q;
    st16bf(S + CK_V + ro, v);
    float kap[16], k2[16], bq[16], ss = 0.f, bon = 0.f;
    { float kkc[16]; ck_ld16(CN + 192 + c0, kkc);
#pragma unroll
      for (int e = 0; e < 16; ++e) { kap[e] = k[e] * kkc[e]; ss += kap[e] * kap[e]; } }
    ss += __shfl_xor(ss, 16); ss += __shfl_xor(ss, 32);
    const float inv = __builtin_amdgcn_rcpf(fmaxf(__builtin_amdgcn_sqrtf(ss), 1e-12f));
    { float kac[16], rkc[16]; ck_ld16(CN + 256 + c0, kac); ck_ld16(CN + 320 + c0, rkc);
#pragma unroll
      for (int e = 0; e < 16; ++e) { kap[e] *= inv; k2[e] = k[e] * (1.0f + (aa[e] - 1.0f) * kac[e]); bq[e] = kap[e] * aa[e]; bon += r[e] * k2[e] * rkc[e]; } }
    bon += __shfl_xor(bon, 16); bon += __shfl_xor(bon, 32);
    if (q == 0) bonus[m * 16 + h] = bon;
    unsigned qkw[8], qrw[8], kbw[8], kkw[8];
#pragma unroll
    for (int e2 = 0; e2 < 8; ++e2) {
        float o_qk[2], o_qr[2], o_kb[2], o_kk[2], o_gm[2];
#pragma unroll
        for (int u = 0; u < 2; ++u) { const int e = 2 * e2 + u;
            float G = lw[e]; G += dpp_mov0<0x111>(G); G += dpp_mov0<0x112>(G); G += dpp_mov0<0x114>(G); G += dpp_mov0<0x118>(G);
            const float eR = __expf(G), eK = __builtin_amdgcn_rcpf(eR);
            const float eQ = __int_as_float(__builtin_amdgcn_update_dpp(0x3f800000, __float_as_int(eR), 0x111, 0xF, 0xF, false));
            o_qk[u] = kap[e] * eQ; o_qr[u] = r[e] * eR; o_kb[u] = bq[e] * eK; o_kk[u] = k2[e] * eK; o_gm[u] = eR; }
        qkw[e2] = pk2f(o_qk[0], o_qk[1]); qrw[e2] = pk2f(o_qr[0], o_qr[1]); kbw[e2] = pk2f(o_kb[0], o_kb[1]); kkw[e2] = pk2f(o_kk[0], o_kk[1]);
        if (j == 15) *(LAS ck_f32x2*)(S + CK_GAM + 64 * q + 8 * e2) = (ck_f32x2){o_gm[0], o_gm[1]};
    }
#define CK_ST(OFF, W) do { *(LAS v4u*)(S + (OFF) + ro) = (v4u){W[0], W[1], W[2], W[3]}; *(LAS v4u*)(S + (OFF) + ro + 16) = (v4u){W[4], W[5], W[6], W[7]}; } while (0)
    CK_ST(CK_QK, qkw); CK_ST(CK_QR, qrw); CK_ST(CK_KB, kbw); CK_ST(CK_KK, kkw);
#undef CK_ST
    if (!(PV & 1)) {
        const int t = lane & 15, g = lane >> 4;
        pg8::bf16x8 aQk[2], aQr[2], bKb[2], bKk[2];
#pragma unroll
        for (int sidx = 0; sidx < 2; ++sidx) { const int off = t * CK_STR + (32 * sidx + 8 * g) * 2;
            aQk[sidx] = *(const LAS pg8::bf16x8*)(S + CK_QK + off); aQr[sidx] = *(const LAS pg8::bf16x8*)(S + CK_QR + off); bKb[sidx] = *(const LAS pg8::bf16x8*)(S + CK_KB + off); bKk[sidx] = *(const LAS pg8::bf16x8*)(S + CK_KK + off); }
        f32x4 ab = {0.f, 0.f, 0.f, 0.f}, ak = ab, br = ab, kr = ab;
#pragma unroll
        for (int sidx = 0; sidx < 2; ++sidx) { ab = __builtin_amdgcn_mfma_f32_16x16x32_bf16(aQk[sidx], bKb[sidx], ab, 0, 0, 0); ak = __builtin_amdgcn_mfma_f32_16x16x32_bf16(aQk[sidx], bKk[sidx], ak, 0, 0, 0);
            br = __builtin_amdgcn_mfma_f32_16x16x32_bf16(aQr[sidx], bKb[sidx], br, 0, 0, 0); kr = __builtin_amdgcn_mfma_f32_16x16x32_bf16(aQr[sidx], bKk[sidx], kr, 0, 0, 0); }
        const int jj = lane & 15;
#pragma unroll
        for (int rg = 0; rg < 4; ++rg) { const int tt = 4 * g + rg; const bool lo = jj < tt, le = jj <= tt;
            ((LAS float*)(S + CK_AB))[jj * 16 + tt] = lo ? ab[rg] : 0.f;
            ((LAS unsigned short*)(S + CK_AK))[tt * 16 + jj] = (unsigned short)pk2f(lo ? ak[rg] : 0.f, 0.f);
            ((LAS unsigned short*)(S + CK_BR))[tt * 16 + jj] = (unsigned short)pk2f(le ? br[rg] : 0.f, 0.f);
            ((LAS unsigned short*)(S + CK_KR))[tt * 16 + jj] = (unsigned short)pk2f(le ? kr[rg] : 0.f, 0.f); }
    }
    if (!(PV & 2)) {
        const int cc = lane & 15; const LAS f32x4* A4 = (const LAS f32x4*)(S + CK_AB); float X[16];
#pragma unroll
        for (int tt = 0; tt < 16; ++tt) X[tt] = (tt == cc) ? 1.0f : 0.0f;
#pragma unroll
        for (int jx = 0; jx < 15; ++jx) {
#pragma unroll
            for (int t4 = (jx + 1) / 4; t4 < 4; ++t4) { const f32x4 a4 = A4[jx * 4 + t4];
#pragma unroll
                for (int e = 0; e < 4; ++e) if (4 * t4 + e > jx) X[4 * t4 + e] -= a4[e] * X[jx]; }
        }
        if (lane < 16) {
#pragma unroll
            for (int tt = 0; tt < 16; ++tt) ((LAS unsigned short*)(S + CK_TP))[tt * 16 + cc] = (unsigned short)pk2f(-X[tt], 0.f); }
    }
}
__device__ __forceinline__ pg8::bf16x8 ck_frag(const v2u lo, const v2u hi) { const v4u w = {lo.x, lo.y, hi.x, hi.y}; return __builtin_bit_cast(pg8::bf16x8, w); }
__device__ __forceinline__ v2u ck_tr(const LAS unsigned char* p) { typedef short v4i16_t __attribute__((ext_vector_type(4))); return __builtin_bit_cast(v2u, __builtin_amdgcn_ds_read_tr16_b64_v4i16((LAS v4i16_t*)p)); }
struct CkFrag { v2u vT, aq[2][2], ar[2][2], ak, tp, br, kr, kb[4], kk[4]; f32x4 gm[4]; };
__device__ __forceinline__ void ck_load(CkFrag& Fg, const LAS unsigned char* S, const int w, const int lane) {
    const int t = lane & 15, g = lane >> 4;
    const int trow = (4 * g + ((lane & 15) >> 2)) * CK_STR + (lane & 3) * 8;
    Fg.vT = ck_tr(S + CK_V + trow + 32 * w);
#pragma unroll
    for (int s = 0; s < 2; ++s) { const int off = t * CK_STR + (32 * s + 4 * g) * 2;
        Fg.aq[s][0] = *(const LAS v2u*)(S + CK_QK + off); Fg.aq[s][1] = *(const LAS v2u*)(S + CK_QK + off + 32); Fg.ar[s][0] = *(const LAS v2u*)(S + CK_QR + off); Fg.ar[s][1] = *(const LAS v2u*)(S + CK_QR + off + 32); }
    const int o16 = (t * 16 + 4 * g) * 2;
    Fg.ak = *(const LAS v2u*)(S + CK_AK + o16); Fg.tp = *(const LAS v2u*)(S + CK_TP + o16); Fg.br = *(const LAS v2u*)(S + CK_BR + o16); Fg.kr = *(const LAS v2u*)(S + CK_KR + o16);
#pragma unroll
    for (int kt = 0; kt < 4; ++kt) { Fg.kb[kt] = ck_tr(S + CK_KB + trow + 32 * kt); Fg.kk[kt] = ck_tr(S + CK_KK + trow + 32 * kt); Fg.gm[kt] = *(const LAS f32x4*)(S + CK_GAM + (16 * kt + 4 * g) * 4); }
}
__device__ __forceinline__ void ck_compute(f32x4 (&St)[4], const CkFrag& Fg, float* yo  , const int lane) {
    const int t = lane & 15, g = lane >> 4; const v2u Z = {0u, 0u};
    pg8::bf16x8 bS[2];
#pragma unroll
    for (int s = 0; s < 2; ++s) { const v2u lo = {pk2f(St[2 * s][0], St[2 * s][1]), pk2f(St[2 * s][2], St[2 * s][3])}, hi = {pk2f(St[2 * s + 1][0], St[2 * s + 1][1]), pk2f(St[2 * s + 1][2], St[2 * s + 1][3])}; bS[s] = ck_frag(lo, hi); }
    f32x4 base = {0.f, 0.f, 0.f, 0.f}, y = base;
    base = __builtin_amdgcn_mfma_f32_16x16x32_bf16(ck_frag(Z, Fg.ak), ck_frag(Z, Fg.vT), base, 0, 0, 0);
#pragma unroll
    for (int s = 0; s < 2; ++s) { base = __builtin_amdgcn_mfma_f32_16x16x32_bf16(ck_frag(Fg.aq[s][0], Fg.aq[s][1]), bS[s], base, 0, 0, 0); y = __builtin_amdgcn_mfma_f32_16x16x32_bf16(ck_frag(Fg.ar[s][0], Fg.ar[s][1]), bS[s], y, 0, 0, 0); }
    const v2u bb = {pk2f(base[0], base[1]), pk2f(base[2], base[3])};
    f32x4 u = __builtin_amdgcn_mfma_f32_16x16x32_bf16(ck_frag(Fg.tp, Z), ck_frag(bb, Z), (f32x4){0.f, 0.f, 0.f, 0.f}, 0, 0, 0);
    const v2u ub = {pk2f(u[0], u[1]), pk2f(u[2], u[3])};
    const pg8::bf16x8 bUV = ck_frag(ub, Fg.vT);
#pragma unroll
    for (int kt = 0; kt < 4; ++kt) {
        St[kt] = __builtin_amdgcn_mfma_f32_16x16x32_bf16(ck_frag(Fg.kb[kt], Fg.kk[kt]), bUV, St[kt], 0, 0, 0); }
    y = __builtin_amdgcn_mfma_f32_16x16x32_bf16(ck_frag(Fg.br, Fg.kr), bUV, y, 0, 0, 0);
#pragma unroll
    for (int kt = 0; kt < 4; ++kt) St[kt] = St[kt] * Fg.gm[kt];
#pragma unroll
    for (int rg = 0; rg < 4; ++rg) yo[(size_t)(4 * g + rg) * 1024 + t] = y[rg];
}
__device__ __forceinline__ unsigned char* ck_image_base(Frame& F, const int head) {
    constexpr size_t HB = (size_t)128 * CK_IMG_BYTES;
    if (head < 36) return (unsigned char*)F.out + 65 * MiB + (size_t)head * HB;
    if (head < 51) return F.ws + WS_WIN + (size_t)(head - 36) * HB;
    if (head < 60) return F.ws + WS_MODP + (size_t)(head - 51) * HB;
    return F.ws + WS_LA + (size_t)(head - 60) * HB;
}
static_assert((size_t)15 * 128 * CK_IMG_BYTES <= 27 * MiB && (size_t)9 * 128 * CK_IMG_BYTES <= 16 * MiB && (size_t)4 * 128 * CK_IMG_BYTES <= 12 * MiB && 65 * MiB + (size_t)36 * 128 * CK_IMG_BYTES <= 128 * MiB, "chunk image parking");
template <int PV = 0> __device__ __forceinline__ void p5a_preproduce(Frame& F) {
    const int lane = mk_lane_id(), wave = F.wave; const int gw = F.vcu * NWAVES + wave, NGW = F.G * NWAVES;
    LAS unsigned char* L = F.lds; LAS unsigned char* S = L + wave * CK_SLOT; LAS float* CN = (LAS float*)(L + CK_CONST + wave * 1536);
    const bf16* P = (const bf16*)(F.ws + WS_P); const bf16* L2 = (const bf16*)(F.ws + WS_L2); float* bonus = (float*)((unsigned char*)F.out + BON_OFF);
    const float* murkv = inp(I_MURKV); const float* pkk = inp(I_KK); const float* pka = inp(I_KA); const float* prk = inp(I_RK);
    constexpr int NPRE = CK_PRE0 < 256 ? 256 - CK_PRE0 : 1;
    for (int task = gw; task < 64 * (256 - CK_PRE0); task += NGW) {
        const int head = task / NPRE, c = CK_PRE0 + task % NPRE, b = head >> 4, h = head & 15; const size_t m0 = (size_t)b * SEQ;
#pragma unroll
        for (int i = 0; i < 6; ++i) { const float* src = i < 3 ? murkv + i * 1024 : i == 3 ? pkk : i == 4 ? pka : prk; CN[i * 64 + lane] = src[h * 64 + lane]; }
        CkRaw R; ck_fetch(R, P, L2, m0, c, h, lane);
        ck_produce<PV>(R, S, CN, bonus, m0, c, h, lane);
        unsigned char* dst = ck_image_base(F, head) + (size_t)(c - CK_PRE0) * CK_IMG_BYTES;
#pragma unroll
        for (int i = 0; i < CK_IMG_BYTES / 1024; ++i) *(GAS v4u*)(dst + i * 1024 + lane * 16) = *(const LAS v4u*)(S + i * 1024 + lane * 16);
    }
}
#define CK_BARRIER() asm volatile("s_waitcnt lgkmcnt(0)\n\ts_barrier" ::: "memory")
template <int VAR = 0> __device__ __forceinline__ void p5_rwkv_scan(Frame& F, const int sidx) {
    const int lane = mk_lane_id(), wave = F.wave, b = sidx >> 4, h = sidx & 15;
    LAS unsigned char* L = F.lds; const bf16* P = (const bf16*)(F.ws + WS_P); const bf16* L2 = (const bf16*)(F.ws + WS_L2);
    float* yraw = (float*)((unsigned char*)F.out + YRAW_OFF); float* bonus = (float*)((unsigned char*)F.out + BON_OFF);
    const size_t m0 = (size_t)b * SEQ; constexpr int NI = SEQ / (16 * CK_NSLOT);
    LAS float* CN = (LAS float*)(L + CK_CONST);
    { const int tid = wave * 64 + lane; if (tid < 384) { const int a = tid >> 6, cc = tid & 63; const float* src = a < 3 ? inp(I_MURKV) + a * 1024 : a == 3 ? inp(I_KK) : a == 4 ? inp(I_KA) : inp(I_RK); CN[tid] = src[h * 64 + cc]; } }
    f32x4 St[4];
#pragma unroll
    for (int kt = 0; kt < 4; ++kt) St[kt] = (f32x4){0.f, 0.f, 0.f, 0.f};
    CkRaw R; ck_fetch(R, P, L2, m0, wave, h, lane);
    __syncthreads();
    const unsigned char* img = ck_image_base(F, sidx);
    for (int it = 0; it < NI; ++it) {
        if (CK_NSLOT * it < CK_PRE0) {
            if (!(VAR & 2)) ck_produce<(VAR >> 2) & 3>(R, L + wave * CK_SLOT, CN, bonus, m0, CK_NSLOT * it + wave, h, lane);
            if (CK_NSLOT * (it + 1) < CK_PRE0) ck_fetch(R, P, L2, m0, CK_NSLOT * (it + 1) + wave, h, lane);
        } else {
            const unsigned char* src = img + (size_t)(CK_NSLOT * it + wave - CK_PRE0) * CK_IMG_BYTES + lane * 16; const unsigned dstl = (unsigned)(uintptr_t)(L + wave * CK_SLOT);
#pragma unroll
            for (int i = 0; i < CK_IMG_BYTES / 1024; ++i) attn_body::glds16(src + i * 1024, (unsigned)__builtin_amdgcn_readfirstlane(dstl + i * 1024));
            asm volatile("s_waitcnt vmcnt(0)" ::: "memory");
        }
        CK_BARRIER();
        if (wave < 4 && !(VAR & 1)) {
            float* yo = yraw + (m0 + (size_t)(CK_NSLOT * it) * 16) * 1024 + h * 64 + 16 * wave;
            CkFrag FA, FB; ck_load(FA, L, wave, lane);
#pragma unroll
            for (int cc = 0; cc < CK_NSLOT; cc += 2) {
                ck_load(FB, L + (cc + 1) * CK_SLOT, wave, lane); ck_compute(St, FA, yo + (size_t)cc * 16 * 1024, lane);
                if (cc + 2 < CK_NSLOT) ck_load(FA, L + (cc + 2) * CK_SLOT, wave, lane);
                ck_compute(St, FB, yo + (size_t)(cc + 1) * 16 * 1024, lane);
            }
        }
        CK_BARRIER();
    }
}
constexpr int CV_OUT = 32 * 64, CV_UP = 32 * 352, CV_DN = 88 * 64, CV_UNITS = (CV_OUT + CV_UP + CV_DN) / 64;
static_assert((CV_OUT + CV_UP + CV_DN) % 64 == 0 && CV_UNITS == 296, "conversion units");
__device__ __forceinline__ void conv_unit(Frame& F, const int cid) {
    const int lane = mk_lane_id(); LAS float* scr = (LAS float*)(F.lds + RING_OFF + F.wave * 8704);
    bf16* WOUT_T = (bf16*)(F.ws + WS_WOUT); bf16* WUP_T = (bf16*)(F.ws + WS_WUP); bf16* WDN_T = (bf16*)(F.ws + WS_WDN);
#pragma unroll 1
    for (int j = 0; j < 8; ++j) { int r = cid * 64 + F.wave * 8 + j;
        if (r < CV_OUT) { const int n0 = 32 * (r % 64), l = n0 & 255; transpose_item(inp(I_WOUT), 2048, WOUT_T, 2048, 64 * (r / 64), n0, (n0 & ~255) + 128 * ((l >> 5) & 1) + 32 * (l >> 6), nullptr, 0, scr, lane); continue; } r -= CV_OUT;
        if (r < CV_UP) { const int n0 = 32 * (r % 352), bj = n0 >= DFF, rr = n0 - bj * DFF;
            transpose_item(inp(I_WUP), NUP, WUP_T, 2048, 64 * (r / 352), n0, 256 * (rr >> 7) + 128 * bj + (rr & 127), nullptr, 0, scr, lane); continue; } r -= CV_UP;
        { const int n0 = 32 * (r % 64), l = n0 & 255; transpose_item(inp(I_WDN), 2048, WDN_T, DFF, 64 * (r / 64), n0, (n0 & ~255) + 128 * ((l >> 5) & 1) + 32 * (l >> 6), nullptr, 0, scr, lane); } }
}
__device__ __forceinline__ void p6_queue(Frame& F, const attn_body::AttnArgs& T) {
    volatile LAS unsigned* slot = F.MISC + 16; const int wid = F.wave; char* lds = (char*)(unsigned char*)F.lds;
    constexpr int NLATE = 0  , NPAIR = 512, NU = NPAIR + CV_UNITS + NLATE;
    static_assert(CV_UNITS <= NPAIR, "interleave");
    static_assert(8 * 8704 <= attn_body::LDS_TAB && attn_body::LDS_BYTES <= attn_body::LDS_TAB && attn_body::LDS_TAB + 8 * attn_body::TAB_N * 4 <= LDSCTL_OFF, "phase-6 LDS map");
    { const int lane = mk_lane_id(); LAS float* tl = (LAS float*)(F.lds + attn_body::LDS_TAB);
      for (int i = wid * 64 + lane; i < 8 * attn_body::TAB_N; i += 512) tl[i] = T.tab[i];
      if (wid == 0 && lane == 0) { const unsigned u = __hip_atomic_fetch_add(T.qctr, 1u, __ATOMIC_RELAXED, __HIP_MEMORY_SCOPE_AGENT); slot[0] = u; } }
    asm volatile("s_waitcnt vmcnt(0) lgkmcnt(0)\n\ts_barrier" ::: "memory");
    const float* lamp = (const float*)(F.ws + WS_LAM); const float* subg = inp(I_SUBG); attn_body::bf16* PQ = (attn_body::bf16*)(F.ws + WS_P);
    for (;;) {
        const int u0 = __builtin_amdgcn_readfirstlane((int)slot[0]);
        if (u0 >= NU) break;
        const int u = u0 - NLATE;
        if (u < 0 || (u < 2 * CV_UNITS && (u & 1) == 1)) {
            if (u < 0) p3_late_mod(F, u0); else conv_unit(F, u >> 1);
            asm volatile("s_waitcnt lgkmcnt(0)\n\ts_barrier" ::: "memory");
            if (wid == 0 && mk_lane_id() == 0) { const unsigned n = __hip_atomic_fetch_add(T.qctr, 1u, __ATOMIC_RELAXED, __HIP_MEMORY_SCOPE_AGENT); slot[0] = n; }
            asm volatile("s_waitcnt vmcnt(0) lgkmcnt(0)\n\ts_barrier" ::: "memory");
            continue; }
        const int idx = u < 2 * CV_UNITS ? (u >> 1) : u - CV_UNITS;
        const int qb = (int)((0x123486957abcdefull >> (4 * (idx >> 5))) & 15ull), sg = idx & 31, b = sg >> 3, h = sg & 7;
#pragma unroll 1
        for (int ih = 0; ih < 2; ++ih) {
            const int qcol = 2048 + h * 128 + ih * 64, kcol = h * 128 + ih * 64, vcol = 1024 + h * 128, ocol = h * 256;
            attn_body::attn_unit<8>(b, qcol, kcol, vcol, ocol, qb, T.P, T.O, lds, wid, h * attn_body::TAB_N, T.qctr, slot, ih == 1, PQ, PC_Q + h * 128, lamp, subg);
        }
    }
}
__device__ __forceinline__ void p6_combine(Frame& F) {
    const int gw = F.vcu * NWAVES + F.wave, NGW = F.G * NWAVES, lane = mk_lane_id();
    {
    const bf16* WUP_T = (const bf16*)(F.ws + WS_WUP); const float* mod = (const float*)(F.ws + WS_MOD); float* biasf = (float*)(F.ws + WS_BIASF);
    float shv[4][4][8];
#pragma unroll
    for (int b = 0; b < 4; ++b)
#pragma unroll
        for (int it = 0; it < 4; ++it) ld8f(mod + (size_t)b * 12288 + 6144 + it * 512 + lane * 8, shv[b][it]);
    for (int col = gw; col < NUP; col += NGW) { float a[4] = {0.f, 0.f, 0.f, 0.f};
#pragma unroll
        for (int it = 0; it < 4; ++it) { const int k0 = it * 512 + lane * 8; const v4u w = *(const GAS v4u*)(WUP_T + (size_t)col * 2048 + k0);
            const float x[8] = {bflo(w.x), bfhi(w.x), bflo(w.y), bfhi(w.y), bflo(w.z), bfhi(w.z), bflo(w.w), bfhi(w.w)};
#pragma unroll
            for (int b = 0; b < 4; ++b) {
#pragma unroll
                for (int e = 0; e < 8; ++e) a[b] += x[e] * shv[b][it][e]; } }
        const int lcol = ((col >> 7) & 1) * DFF + (col >> 8) * 128 + (col & 127);
#pragma unroll
        for (int b = 0; b < 4; ++b) { const float s = wave_sum(a[b]); if (lane == 0) biasf[(size_t)b * NUP + lcol] = s; }
    }
    }
    bf16* P = (bf16*)(F.ws + WS_P);
    const int hh = lane >> 2, chn = hh * 64 + (lane & 3) * 16;
    const float* yraw = (const float*)((const unsigned char*)F.out + YRAW_OFF); const float* bonus = (const float*)((const unsigned char*)F.out + BON_OFF); const bf16* L2 = (const bf16*)(F.ws + WS_L2);
    float muv[16], lng[16], lnb[16];
    { const float* pm = inp(I_MURKV) + 2048 + chn; const float* pg = inp(I_LNG) + chn; const float* pb = inp(I_LNB) + chn; ld8f(pm, muv); ld8f(pm + 8, muv + 8); ld8f(pg, lng); ld8f(pg + 8, lng + 8); ld8f(pb, lnb); ld8f(pb + 8, lnb + 8); }
    struct TokIn { f32x4 y[4]; v4u va, vb, pa, pb2, ga, gb; float bon; };
    auto ldtok = [&](const int m, TokIn& T) {
        const float* yp = yraw + (size_t)m * 1024 + chn;
#pragma unroll
        for (int i = 0; i < 4; ++i) T.y[i] = *(const GAS f32x4*)(yp + 4 * i);
        const bf16* pr = P + (size_t)m * NP + PC_VR + chn; const bf16* pp = ((m & (SEQ - 1)) != 0) ? pr - NP : pr;
        T.va = *(const GAS v4u*)pr; T.vb = *(const GAS v4u*)(pr + 8); T.pa = *(const GAS v4u*)pp; T.pb2 = *(const GAS v4u*)(pp + 8);
        T.ga = *(const GAS v4u*)(L2 + (size_t)m * NL2 + 2048 + chn); T.gb = *(const GAS v4u*)(L2 + (size_t)m * NL2 + 2048 + chn + 8);
        T.bon = bonus[(size_t)m * 16 + hh]; };
    auto fintok = [&](const int m, const TokIn& T) {
        {
            float y[16] = {T.y[0].x, T.y[0].y, T.y[0].z, T.y[0].w, T.y[1].x, T.y[1].y, T.y[1].z, T.y[1].w, T.y[2].x, T.y[2].y, T.y[2].z, T.y[2].w, T.y[3].x, T.y[3].y, T.y[3].z, T.y[3].w};
            const float hpm = ((m & (SEQ - 1)) != 0) ? 1.0f : 0.0f;
            float vp[16], vq[16], gg[16]; unpack8(T.va, vp); unpack8(T.vb, vp + 8); unpack8(T.pa, vq); unpack8(T.pb2, vq + 8); unpack8(T.ga, gg); unpack8(T.gb, gg + 8);
            float s1 = 0.f;
#pragma unroll
            for (int e = 0; e < 16; ++e) s1 += y[e];
            s1 = red4(s1); const float mu = s1 * (1.0f / 64.0f); float s2 = 0.f;
#pragma unroll
            for (int e = 0; e < 16; ++e) { y[e] -= mu; s2 += y[e] * y[e]; }
            s2 = red4(s2); const float rs = 1.0f / sqrtf(s2 * (1.0f / 64.0f) + GN_EPS); float o[16];
#pragma unroll
            for (int e = 0; e < 16; ++e) { const float v = vp[e] + (hpm * vq[e] - vp[e]) * muv[e]; o[e] = (y[e] * rs * lng[e] + lnb[e] + T.bon * v) * gg[e]; }
            bf16* dr = P + (size_t)m * NP + PC_R + chn;
            v4u w0, w1; w0.x = pk2(o[0], o[1]); w0.y = pk2(o[2], o[3]); w0.z = pk2(o[4], o[5]); w0.w = pk2(o[6], o[7]); w1.x = pk2(o[8], o[9]); w1.y = pk2(o[10], o[11]); w1.z = pk2(o[12], o[13]); w1.w = pk2(o[14], o[15]);
            *(GAS v4u*)dr = w0; *(GAS v4u*)(dr + 8) = w1;
        }
    };
    for (int m = gw; m < M; m += 2 * NGW) { const int m2 = m + NGW; const bool two = m2 < M; TokIn A, B; ldtok(m, A); ldtok(two ? m2 : m, B); fintok(m, A); if (two) fintok(m2, B); }
}
__device__ __forceinline__ void fixup_tile(Frame& F, const int pm) {
    const int tid = F.wave * 64 + mk_lane_id();
    const float* uph = (const float*)(F.ws + WS_UPH); const float* halo = (const float*)(F.ws + WS_HALO); bf16* ACT = (bf16*)(F.ws + WS_ACT);
    const float* cw = inp(I_CW); const float* cb = inp(I_CB);
    for (int it = tid; it < 4 * (DFF / 8); it += NWAVES * 64) {
        const int j0 = (it % (DFF / 8)) * 8, k = (it / (DFF / 8)) & 1, blk = 2 * pm + it / (2 * (DFF / 8)); const bool seq0 = ((blk * 128) & (SEQ - 1)) == 0;
        const float m1 = (k == 0 && seq0) ? 0.f : 1.f, m2 = seq0 ? 0.f : 1.f;
        const float* p1 = (k == 1 || seq0) ? uph + (size_t)(blk * 2) * NUP : halo + (size_t)((blk - 1) * 2 + 1) * NUP;
        const float* p2 = seq0 ? uph + (size_t)(blk * 2 + k) * NUP : halo + (size_t)((blk - 1) * 2 + k) * NUP;
        float yy[2][8];
#pragma unroll
        for (int hv = 0; hv < 2; ++hv) { const int c = hv * DFF + j0; float u0[8], u1[8], u2[8], w0[8], w1[8], w2[8], bb[8];
            ld8f(uph + (size_t)(blk * 2 + k) * NUP + c, u0); ld8f(p1 + c, u1); ld8f(p2 + c, u2);
            ld8f(cw + c, w0); ld8f(cw + NUP + c, w1); ld8f(cw + 2 * NUP + c, w2); ld8f(cb + c, bb);
#pragma unroll
            for (int e = 0; e < 8; ++e) yy[hv][e] = bb[e] + w0[e] * (m2 * u2[e]) + w1[e] * (m1 * u1[e]) + w2[e] * u0[e]; }
        float o[8];
#pragma unroll
        for (int e = 0; e < 8; ++e) o[e] = yy[0][e] * sigm(yy[0][e]) * yy[1][e];
        v4u w; w.x = pk2(o[0], o[1]); w.y = pk2(o[2], o[3]); w.z = pk2(o[4], o[5]); w.w = pk2(o[6], o[7]);
        *(GAS v4u*)(ACT + (size_t)(blk * 128 + k) * DFF + j0) = w;
    }
}

#ifndef MK_N_LAUNCHES
#define MK_N_LAUNCHES 1
#endif
constexpr int NPHASE = 11;
__device__ __forceinline__ int mk_opq(int v) { asm volatile("" : "+s"(v)); return v; }
constexpr int N_LAUNCHES = MK_N_LAUNCHES;
struct Args { const float* in[N_IN]; float* out; unsigned char* ws; int ph_lo, ph_hi; };
__global__ void __launch_bounds__(NWAVES * 64, 2) mk_fwd(Args args) {
    extern __shared__ __attribute__((aligned(16))) unsigned char lds[];
    Frame F;
    F.lds = (LAS unsigned char*)lds;
    F.MISC = (volatile LAS unsigned*)(F.lds + MISC_OFF);
    F.wave = __builtin_amdgcn_readfirstlane((int)threadIdx.x >> 6);
    F.G = gridDim.x; { const int bx = blockIdx.x; F.vcu = (F.G % 8 == 0) ? (bx % 8) * (F.G / 8) + bx / 8 : bx; }
    F.ws = args.ws; F.out = args.out; F.ctl = (gu32*)(args.ws + WS_CTL);
    for (int u = F.wave * 64 + mk_lane_id(); u < (LDS_BYTES - LDSCTL_OFF) / 4; u += NWAVES * 64) ((LAS unsigned*)(F.lds + LDSCTL_OFF))[u] = 0u;
    __syncthreads();
    XcdBarrier bar; bar.bar = (unsigned*)(F.ctl + CW_BAR); bar.x = 0; bar.st = nullptr;
    if (N_LAUNCHES == 1) bar = xcd_barrier_post((unsigned*)(F.ctl + CW_BAR), F.MISC + 8, F.wave == 0 && mk_lane_id() == 0);
    const int lo = args.ph_lo, hi = args.ph_hi;
#define IN(k) (lo <= (k) && (k) < hi)
#ifndef PROBE_MASK
#define PROBE_MASK 0
#endif
#ifndef PROBE_NREP
#define PROBE_NREP 2
#endif
#define REP(k) for (int rep_ = 0; rep_ < (((PROBE_MASK >> (k)) & 1) ? PROBE_NREP : 1); ++rep_)
#define SEAM(k) do { if (IN(k) && IN((k) + 1)) xcd_barrier(bar, F.wave == 0 && mk_lane_id() == 0); } while (0)
    unsigned char* ws = args.ws;
    bf16* H = (bf16*)(ws + WS_H); bf16* P = (bf16*)(ws + WS_P); bf16* LA = (bf16*)(ws + WS_LA); bf16* L2 = (bf16*)(ws + WS_L2);
    float* mod = (float*)(ws + WS_MOD);

    if (IN(0)) { REP(0) p0_prologue(F); } SEAM(0);
    if (IN(2)) { REP(2) p1_hnorm(F); } SEAM(2);
    if (IN(3)) REP(3) {
        pg8::Gemm g{H, H, 1 << 30, 2048, (const bf16*)(ws + WS_WIN), M, NP, 2048}; pg8::StaticOrder S; S.init(M, NP, F.G, (int)blockIdx.x);
        pg8::EpiStoreQK E{P, NP, inp(I_QNG), inp(I_KNG), QSCALE};
        pg8::gemm_phase<pg8::EpiStoreQK, pg8::StaticOrder, true, true>(F.lds + RING_OFF, g, S, E, F.wave);
        { const int rem = ((M / 256) * (NP / 256)) % F.G; asm volatile("s_waitcnt vmcnt(0) lgkmcnt(0)" ::: "memory"); __syncthreads();
          if (rem != 0) { if ((int)blockIdx.x >= rem) for (int q = (int)blockIdx.x - rem; q < N_LATE_UNITS; q += F.G - rem) p3_late_mod(F, q); }
          else for (int q = F.vcu; q < N_LATE_UNITS; q += F.G) p3_late_mod(F, q); }
    } SEAM(3);
    if (IN(4)) { p3_prep(F); } SEAM(4);
    if (IN(5)) REP(5) {
        int kw = 256, kw2 = 128; asm volatile("" : "+s"(kw), "+s"(kw2));
        pg8::Gemm g{LA, LA, 1 << 30, KL2, (const bf16*)(ws + WS_WL2), M, NL2, kw, KL2, 8, 128, kw2}; pg8::StaticOrder S; S.init(M, NL2, F.G, (int)blockIdx.x);
        pg8::EpiLora2 E{L2, inp(I_W0), inp(I_A0)};
        pg8::gemm_phase<pg8::EpiLora2, pg8::StaticOrder, true, true>(F.lds + RING_OFF, g, S, E, F.wave);
    } SEAM(5);
#ifdef PROBE6N
    if (IN(6)) for (;;) {
        if (__builtin_amdgcn_readfirstlane((int)F.MISC[24]) > 0) xcd_barrier(bar, F.wave == 0 && mk_lane_id() == 0);
        if (CK_PRE0 < 256) { p5a_preproduce(F); xcd_barrier(bar, F.wave == 0 && mk_lane_id() == 0); }
        for (int hd = F.vcu; hd < 64; hd += F.G) p5_rwkv_scan(F, hd);
        { const int rq = __builtin_amdgcn_readfirstlane((int)F.MISC[24]);
          const attn_body::AttnArgs AT{(const attn_body::bf16*)P, (attn_body::bf16*)(ws + WS_OBUF), (const float*)(ws + WS_ATAB), (unsigned*)(F.ctl + CW_ATTQ + 64 * rq)};
          p6_queue(F, AT); }
        __syncthreads(); const int r1 = __builtin_amdgcn_readfirstlane((int)F.MISC[24]) + 1; __syncthreads();
        if (F.wave == 0 && mk_lane_id() == 0) F.MISC[24] = (unsigned)r1;
        __syncthreads(); if (r1 >= PROBE6N) break;
    } SEAM(6);
#else
    if (IN(6)) REP(6) {
#ifdef PROBE_SCANX
        { if (F.G >= 64) { const int hd = (F.vcu * 64) / F.G; if (F.vcu == 0 || ((F.vcu - 1) * 64) / F.G != hd) p5_rwkv_scan<PROBE_SCANX>(F, hd); }
          xcd_barrier(bar, F.wave == 0 && mk_lane_id() == 0); }
#endif
        if (CK_PRE0 < 256) { p5a_preproduce(F);
        xcd_barrier(bar, F.wave == 0 && mk_lane_id() == 0); }
        for (int hd = F.vcu; hd < 64; hd += F.G) p5_rwkv_scan(F, hd);
        const attn_body::AttnArgs AT{(const attn_body::bf16*)P, (attn_body::bf16*)(ws + WS_OBUF), (const float*)(ws + WS_ATAB), (unsigned*)(F.ctl + CW_ATTQ + 64 * rep_)};
        p6_queue(F, AT);
#ifdef PROBE_CONV2
        for (int cid = F.vcu; cid < CV_UNITS; cid += F.G) conv_unit(F, cid);
#endif
    } SEAM(6);
#endif
    if (IN(7)) { REP(7) p6_combine(F); } SEAM(7);
    if (IN(8)) {
        pg8::Gemm g{P + PC_Q, P + PC_Q, 1 << 30, NP, (const bf16*)(ws + WS_WOUT), M, 2048, 2048}; pg8::StaticOrder S; S.init(M, 2048, F.G, (int)blockIdx.x);
        pg8::EpiOut E{inp(I_X), (bf16*)(ws + WS_X1B), (bf16*)(ws + WS_XG), (float*)(ws + WS_ROWSS), mod + 4096, (const float*)(ws + WS_GSF), 12288};
        pg8::gemm_phase<pg8::EpiOut, pg8::StaticOrder, true, true>(F.lds + RING_OFF, g, S, E, F.wave);
    } SEAM(8);
#ifdef PROBE_UPPLAIN
    if (IN(9)) {
        const bf16* XG = (const bf16*)(ws + WS_XG);
        pg8::Gemm g{XG, XG, 1 << 30, 2048, (const bf16*)(ws + WS_WUP), M, NUP, 2048}; pg8::StaticOrder S; S.init(M, NUP, F.G, (int)blockIdx.x);
        pg8::EpiStore E{(bf16*)(ws + 160 * MiB), NUP};
        pg8::gemm_phase<pg8::EpiStore, pg8::StaticOrder, true, true>(F.lds + RING_OFF, g, S, E, F.wave);
    }
#endif
    if (IN(9)) REP(9) {
        const bf16* XG = (const bf16*)(ws + WS_XG);
        pg8::Gemm g{XG, XG, 1 << 30, 2048, (const bf16*)(ws + WS_WUP), M, NUP, 2048}; pg8::StaticOrder S; S.init(M, NUP, F.G, (int)blockIdx.x);
        pg8::EpiUpGlu E{(bf16*)(ws + WS_ACT), (const float*)(ws + WS_ROWSS), (const float*)(ws + WS_BIASF), inp(I_CW), inp(I_CB), (float*)(ws + WS_UPH), (float*)(ws + WS_HALO)};
        pg8::gemm_phase<pg8::EpiUpGlu, pg8::StaticOrder, true, true>(F.lds + RING_OFF, g, S, E, F.wave);
    } SEAM(9);
    if (IN(10)) {
        const bf16* ACT = (const bf16*)(ws + WS_ACT);
        pg8::Gemm g{ACT, ACT, 1 << 30, DFF, (const bf16*)(ws + WS_WDN), M, 2048, DFF}; pg8::StaticOrder S; S.init(M, 2048, F.G, (int)blockIdx.x);
        { pg8::Unit u; int last = -1; for (int i = 0; S.next(i, u); ++i) { if (u.pm != last) fixup_tile(F, u.pm); last = u.pm; } }
        asm volatile("s_waitcnt vmcnt(0)" ::: "memory"); __syncthreads();
        pg8::EpiDown E{F.out, (const bf16*)(ws + WS_X1B), mod + 10240, 12288};
        pg8::gemm_phase<pg8::EpiDown, pg8::StaticOrder, true, true>(F.lds + RING_OFF, g, S, E, F.wave);
    }
#undef IN
#undef SEAM
}

extern "C" void kernel_launch(void* const* d_in, const int* in_sizes, int n_in, void* d_out, int out_size, void* d_ws, size_t ws_size, hipStream_t stream) {
    static int grid = 0;
    if (grid == 0) {
        if (n_in != N_IN || in_sizes[0] != M * DMODEL || out_size != M * DMODEL || ws_size < WS_END) {
            fprintf(stderr, "kernel_launch: shape/workspace mismatch: n_in %d in0 %d out %d ws %zu (need %zu); nothing launched\n", n_in, n_in > 0 ? in_sizes[0] : -1, out_size, ws_size, (size_t)WS_END); grid = -1; return; }
        int dev = 0, cus = 0, per_cu = 0;
        if (hipGetDevice(&dev) != hipSuccess || hipDeviceGetAttribute(&cus, hipDeviceAttributeMultiprocessorCount, dev) != hipSuccess) { fprintf(stderr, "kernel_launch: device query failed\n"); grid = -1; return; }
        if (hipFuncSetAttribute((const void*)mk_fwd, hipFuncAttributeMaxDynamicSharedMemorySize, LDS_BYTES) != hipSuccess) { fprintf(stderr, "kernel_launch: hipFuncSetAttribute failed\n"); grid = -1; return; }
        if (hipOccupancyMaxActiveBlocksPerMultiprocessor(&per_cu, (const void*)mk_fwd, NWAVES * 64, LDS_BYTES) != hipSuccess || per_cu < 1) { fprintf(stderr, "kernel_launch: occupancy query says %d blocks per CU\n", per_cu); per_cu = 1; }
        (void)hipGetLastError();
        grid = cus;
        if (grid % 8 != 0 || grid < 64) fprintf(stderr, "kernel_launch: unexpected CU count %d\n", grid);
    }
    if (grid < 0) return;
    (void)hipMemsetAsync((char*)d_ws + WS_CTL, 0, CTL_ZERO_BYTES, stream);
    Args a{};
    for (int i = 0; i < N_IN; ++i) a.in[i] = (const float*)d_in[i];
    a.out = (float*)d_out; a.ws = (unsigned char*)d_ws;
#ifdef PROBE_RN
    if (PROBE_RLO > 0) { a.ph_lo = 0; a.ph_hi = PROBE_RLO; hipLaunchKernelGGL(mk_fwd, dim3(grid), dim3(NWAVES * 64), LDS_BYTES, stream, a); }
    for (int r = 0; r < PROBE_RN; ++r) { (void)hipMemsetAsync((char*)d_ws + WS_CTL, 0, CTL_ZERO_BYTES, stream); a.ph_lo = PROBE_RLO; a.ph_hi = PROBE_RHI; hipLaunchKernelGGL(mk_fwd, dim3(grid), dim3(NWAVES * 64), LDS_BYTES, stream, a); }
    (void)hipMemsetAsync((char*)d_ws + WS_CTL, 0, CTL_ZERO_BYTES, stream); a.ph_lo = PROBE_RHI; a.ph_hi = NPHASE; hipLaunchKernelGGL(mk_fwd, dim3(grid), dim3(NWAVES * 64), LDS_BYTES, stream, a);
    if (false)
#endif
    if (N_LAUNCHES == 1) { a.ph_lo = 0; a.ph_hi = NPHASE; hipLaunchKernelGGL(mk_fwd, dim3(grid), dim3(NWAVES * 64), LDS_BYTES, stream, a); }
    else for (int li = 0; li < NPHASE; ++li) { a.ph_lo = li; a.ph_hi = li + 1; hipLaunchKernelGGL(mk_fwd, dim3(grid), dim3(NWAVES * 64), LDS_BYTES, stream, a); }
    const hipError_t le = hipPeekAtLastError();
    if (le != hipSuccess) fprintf(stderr, "kernel_launch: launch failed: %s\n", hipGetErrorName(le));
}
```
